# Optimizing an MI355X kernel written in HIP

```python
import numpy as np
import jax
import jax.numpy as jnp
from jax import lax

D_MODEL = 1024
BATCH = 2
SEQ = 16384
DEPTH = 4

HEAD_DIM = 64
RET_HEADS = 8
RWKV_HEADS = 8
RET_WIDTH = RET_HEADS * HEAD_DIM
RWKV_WIDTH = RWKV_HEADS * HEAD_DIM
MIX_WIDTH = RET_WIDTH + RWKV_WIDTH
RET_CHUNK = 128
ROPE_BASE = 10000.0
RET_GN_EPS = 1e-6
W_LORA = 64
A_LORA = 64
G_LORA = 128
RWKV_GN_EPS = 64e-5
RWKV_SHIFT_WIDTH = 3 * RWKV_WIDTH + W_LORA + A_LORA + G_LORA
EVEN_IN = 4 * RET_WIDTH + RWKV_SHIFT_WIDTH
SWA_HEADS = 16
SWA_KV_HEADS = 4
SWA_GROUP = SWA_HEADS // SWA_KV_HEADS
SWA_WINDOW = 128
SWA_WIDTH = SWA_HEADS * HEAD_DIM
SWA_QKV = (SWA_HEADS + 2 * SWA_KV_HEADS) * HEAD_DIM
D_FF = -(-8 * D_MODEL // (3 * 256)) * 256
RMS_EPS = 1e-6
N_EVEN = (DEPTH + 1) // 2
N_ODD = DEPTH // 2

kernel_name = 'hybrid_retention_rwkv7_swa_sink_trunk'


def rms_norm(x, g):
    xf = x.astype(jnp.float32)
    y = xf * lax.rsqrt(jnp.mean(xf * xf, axis=-1, keepdims=True) + RMS_EPS)
    return (y * g.astype(jnp.float32)).astype(x.dtype)


def head_group_norm(y, eps, gain=None, bias=None):
    yf = y.astype(jnp.float32)
    mu = jnp.mean(yf, axis=-1, keepdims=True)
    var = jnp.mean(jnp.square(yf - mu), axis=-1, keepdims=True)
    out = (yf - mu) * lax.rsqrt(var + eps)
    if gain is not None:
        out = out * gain.astype(jnp.float32) + bias.astype(jnp.float32)
    return out.astype(y.dtype)


def rotary(x, pos):
    half = x.shape[-1] // 2
    inv_freq = ROPE_BASE ** (-jnp.linspace(0.0, 1.0, half))
    ang = pos[:, None] * inv_freq[None, :]
    cos = jnp.cos(ang)[None, :, None, :].astype(x.dtype)
    sin = jnp.sin(ang)[None, :, None, :].astype(x.dtype)
    x1, x2 = x[..., :half], x[..., half:]
    return jnp.concatenate([x1 * cos - x2 * sin, x1 * sin + x2 * cos], axis=-1)


def token_shift(z):
    return jnp.pad(z, ((0, 0), (1, 0), (0, 0)))[:, :-1]


def chunk_retention(q, k, v):
    B, T, H, D = q.shape
    C = RET_CHUNK
    N = T // C
    log_gamma = jnp.log1p(-(2.0 ** (-5.0 - jnp.arange(H, dtype=jnp.float32))))
    q = q.reshape(B, N, C, H, D)
    k = k.reshape(B, N, C, H, D)
    v = v.reshape(B, N, C, H, D)
    idx = jnp.arange(C, dtype=jnp.float32)
    rel = idx[:, None] - idx[None, :]
    inner_decay = jnp.where(rel >= 0, jnp.exp(jnp.maximum(rel, 0.0)[None] * log_gamma[:, None, None]), 0.0)
    scores = jnp.einsum('bnihd,bnjhd->bnhij', q, k) * inner_decay.astype(q.dtype)
    o_inner = jnp.einsum('bnhij,bnjhd->bnihd', scores, v)
    k_dec = jnp.exp((C - 1 - idx)[:, None] * log_gamma[None, :]).astype(q.dtype)
    kv = jnp.einsum('bnjhd,bnjhe->nbhde', k * k_dec[:, :, None], v)
    chunk_decay = jnp.exp(C * log_gamma)[None, :, None, None].astype(kv.dtype)

    def step(state, kv_c):
        return chunk_decay * state + kv_c, state

    _, s_prev = lax.scan(step, jnp.zeros_like(kv[0]), kv)
    q_dec = jnp.exp((idx + 1.0)[:, None] * log_gamma[None, :]).astype(q.dtype)
    o_cross = jnp.einsum('bnihd,nbhde->bnihe', q * q_dec[:, :, None], s_prev)
    return (o_inner + o_cross).reshape(B, T, H, D)


def rwkv7_scan(r, w, k, v, a, b):
    B, T, H, D = r.shape

    def step(state, inp):
        r_t, w_t, k_t, v_t, a_t, b_t = inp
        sa = jnp.einsum('bhij,bhj->bhi', state, a_t)
        state = state * w_t[:, :, None, :] + sa[..., None] * b_t[:, :, None, :] + v_t[..., None] * k_t[:, :, None, :]
        return state, jnp.einsum('bhij,bhj->bhi', state, r_t)

    xs = tuple(jnp.moveaxis(t, 1, 0) for t in (r, w, k, v, a, b))
    _, y = lax.scan(step, jnp.zeros((B, H, D, D), r.dtype), xs)
    return jnp.moveaxis(y, 0, 1)


def retention_rwkv_mixer(h, w_in, w_out, mu, w0, w_up, a0, a_up, g_up, k_k, k_a, r_k, ln_g, ln_b):
    B, T, _ = h.shape

    def heads(t):
        return t.reshape(B, T, -1, HEAD_DIM)

    z = h @ w_in
    z_ret, z_rwkv = z[..., :4 * RET_WIDTH], z[..., 4 * RET_WIDTH:]

    q, k, v, g = jnp.split(z_ret, 4, axis=-1)
    pos = jnp.arange(T, dtype=jnp.float32)
    q = rotary(heads(q), pos)
    k = rotary(heads(k), pos) * HEAD_DIM ** -0.5
    o = chunk_retention(q, k, heads(v))
    ret_out = head_group_norm(o, RET_GN_EPS).reshape(B, T, RET_WIDTH) * jax.nn.silu(g)

    zs = z_rwkv + mu * (token_shift(z_rwkv) - z_rwkv)
    split_at = [RWKV_WIDTH, 2 * RWKV_WIDTH, 3 * RWKV_WIDTH,
                3 * RWKV_WIDTH + W_LORA, 3 * RWKV_WIDTH + W_LORA + A_LORA]
    rr, kr, vr, wl, al, gl = jnp.split(zs, split_at, axis=-1)
    w_log = -jax.nn.softplus(-(w0 + jnp.tanh(wl) @ w_up)) - 0.5
    decay = jnp.exp(-jnp.exp(w_log))
    a = jax.nn.sigmoid(a0 + al @ a_up)
    gate = jax.nn.sigmoid(gl) @ g_up
    kkf = heads(kr * k_k).astype(jnp.float32)
    kk = (kkf / jnp.maximum(jnp.linalg.norm(kkf, axis=-1, keepdims=True), 1e-12)).astype(kr.dtype)
    kr = kr * (1.0 + (a - 1.0) * k_a)
    r_h, k_h, v_h = heads(rr), heads(kr), heads(vr)
    y = rwkv7_scan(r_h, heads(decay), k_h, v_h, -kk, kk * heads(a))
    y = head_group_norm(y, RWKV_GN_EPS, ln_g, ln_b)
    bonus = jnp.sum(r_h * k_h * r_k, axis=-1, keepdims=True) * v_h
    rwkv_out = (y + bonus).reshape(B, T, RWKV_WIDTH) * gate

    return jnp.concatenate([ret_out, rwkv_out], axis=-1) @ w_out


def swa_sink_mixer(h, w_qkv, b_qkv, sinks, w_o, b_o):
    B, T, _ = h.shape
    W = SWA_WINDOW
    NB = T // W
    z = h @ w_qkv + b_qkv
    q, k, v = jnp.split(z, [SWA_WIDTH, SWA_WIDTH + SWA_KV_HEADS * HEAD_DIM], axis=-1)
    q = q.reshape(B, NB, W, SWA_KV_HEADS, SWA_GROUP, HEAD_DIM)
    k = k.reshape(B, NB, W, SWA_KV_HEADS, HEAD_DIM)
    v = v.reshape(B, NB, W, SWA_KV_HEADS, HEAD_DIM)

    def with_prev(t):
        prev = jnp.pad(t, ((0, 0), (1, 0), (0, 0), (0, 0), (0, 0)))[:, :-1]
        return jnp.concatenate([prev, t], axis=2)

    kb, vb = with_prev(k), with_prev(v)
    s = jnp.einsum('bnqhgd,bnkhd->bnhgqk', q, kb).astype(jnp.float32) * HEAD_DIM ** -0.5
    qi = jnp.arange(W)[:, None]
    kj = jnp.arange(2 * W)[None, :]
    rel = qi + W - kj
    band = (rel >= 0) & (rel < W)
    valid = band[None] & ((jnp.arange(NB)[:, None, None] > 0) | (kj[None] >= W))
    s = jnp.where(valid[None, :, None, None], s, -jnp.inf)
    sink = sinks.astype(jnp.float32).reshape(SWA_KV_HEADS, SWA_GROUP)[None, None, :, :, None, None]
    m = jnp.maximum(jnp.max(s, axis=-1, keepdims=True), sink)
    e = jnp.exp(s - m)
    p = e / (jnp.sum(e, axis=-1, keepdims=True) + jnp.exp(sink - m))
    o = jnp.einsum('bnhgqk,bnkhd->bnqhgd', p.astype(vb.dtype), vb)
    return o.reshape(B, T, SWA_WIDTH) @ w_o + b_o


def swiglu(h, w_gate, w_up, w_down):
    return (jax.nn.silu(h @ w_gate) * (h @ w_up)) @ w_down


def setup_inputs(seed: int = 0) -> dict:
    key = jax.random.key(seed)
    ks = jax.random.split(key, 25)
    f32 = jnp.float32
    D, H = D_MODEL, RWKV_HEADS

    def nrm(k, shape, scale):
        return jax.random.normal(k, shape, f32) * scale

    return {
        'x': nrm(ks[0], (BATCH, SEQ, D), 1.0),
        'norm1_g': 1.0 + nrm(ks[1], (DEPTH, D), 0.02),
        'norm2_g': 1.0 + nrm(ks[2], (DEPTH, D), 0.02),
        'final_g': 1.0 + nrm(ks[3], (D,), 0.02),
        'even_w_in': nrm(ks[4], (N_EVEN, D, EVEN_IN), D ** -0.5),
        'even_w_out': nrm(ks[5], (N_EVEN, MIX_WIDTH, D), MIX_WIDTH ** -0.5),
        'rwkv_mu': jax.random.uniform(ks[6], (N_EVEN, RWKV_SHIFT_WIDTH), f32),
        'rwkv_w0': nrm(ks[7], (N_EVEN, RWKV_WIDTH), 0.5),
        'rwkv_w_up': nrm(ks[8], (N_EVEN, W_LORA, RWKV_WIDTH), 0.5 * W_LORA ** -0.5),
        'rwkv_a0': nrm(ks[9], (N_EVEN, RWKV_WIDTH), 0.5),
        'rwkv_a_up': nrm(ks[10], (N_EVEN, A_LORA, RWKV_WIDTH), 0.5 * A_LORA ** -0.5),
        'rwkv_g_up': nrm(ks[11], (N_EVEN, G_LORA, RWKV_WIDTH), G_LORA ** -0.5),
        'rwkv_k_k': 0.85 + nrm(ks[12], (N_EVEN, RWKV_WIDTH), 0.05),
        'rwkv_k_a': 1.0 + nrm(ks[13], (N_EVEN, RWKV_WIDTH), 0.05),
        'rwkv_r_k': nrm(ks[14], (N_EVEN, H, HEAD_DIM), 0.1),
        'rwkv_ln_g': 1.0 + nrm(ks[15], (N_EVEN, H, HEAD_DIM), 0.02),
        'rwkv_ln_b': nrm(ks[16], (N_EVEN, H, HEAD_DIM), 0.02),
        'swa_w_qkv': nrm(ks[17], (N_ODD, D, SWA_QKV), D ** -0.5),
        'swa_b_qkv': nrm(ks[18], (N_ODD, SWA_QKV), 0.02),
        'swa_sinks': nrm(ks[19], (N_ODD, SWA_HEADS), 0.5),
        'swa_w_o': nrm(ks[20], (N_ODD, SWA_WIDTH, D), SWA_WIDTH ** -0.5),
        'swa_b_o': nrm(ks[21], (N_ODD, D), 0.02),
        'ffn_w_gate': nrm(ks[22], (DEPTH, D, D_FF), D ** -0.5),
        'ffn_w_up': nrm(ks[23], (DEPTH, D, D_FF), D ** -0.5),
        'ffn_w_down': nrm(ks[24], (DEPTH, D_FF, D), D_FF ** -0.5),
    }


def reference(x, norm1_g, norm2_g, final_g, even_w_in, even_w_out, rwkv_mu, rwkv_w0, rwkv_w_up,
              rwkv_a0, rwkv_a_up, rwkv_g_up, rwkv_k_k, rwkv_k_a, rwkv_r_k, rwkv_ln_g, rwkv_ln_b,
              swa_w_qkv, swa_b_qkv, swa_sinks, swa_w_o, swa_b_o, ffn_w_gate, ffn_w_up, ffn_w_down):
    h = x
    for layer in range(DEPTH):
        i = layer // 2
        n = rms_norm(h, norm1_g[layer])
        if layer % 2 == 0:
            mix = retention_rwkv_mixer(n, even_w_in[i], even_w_out[i], rwkv_mu[i], rwkv_w0[i], rwkv_w_up[i],
                                       rwkv_a0[i], rwkv_a_up[i], rwkv_g_up[i], rwkv_k_k[i], rwkv_k_a[i],
                                       rwkv_r_k[i], rwkv_ln_g[i], rwkv_ln_b[i])
        else:
            mix = swa_sink_mixer(n, swa_w_qkv[i], swa_b_qkv[i], swa_sinks[i], swa_w_o[i], swa_b_o[i])
        h = h + mix
        n = rms_norm(h, norm2_g[layer])
        h = h + swiglu(n, ffn_w_gate[layer], ffn_w_up[layer], ffn_w_down[layer])
    return rms_norm(h, final_g)
```

```cpp
#include <hip/hip_runtime.h>
#include <hip/hip_cooperative_groups.h>
#include <cstdio>
#include <cstdint>
#include <cmath>
namespace cg = cooperative_groups;
#define FUSED 0
namespace pg8 {
#define PG8_LAS __attribute__((address_space(3)))
typedef unsigned short bf16_t;
typedef short bf16x8 __attribute__((ext_vector_type(8)));
typedef float f32x4 __attribute__((ext_vector_type(4)));
typedef unsigned u32x4 __attribute__((ext_vector_type(4)));
constexpr int BM = 256, BK = 64, HALF = 128, HTB = HALF * BK * 2  , STAGE_BYTES = 8 * HTB, NXCD = 8, WGM = 8;

__host__ __device__ __forceinline__ int lds_byte(int r, int c) { const int st = (r >> 4) * 2 + (c >> 5), rr = r & 15, cc = c & 31, ob = rr * 64 + cc * 2; return st * 1024 + (ob ^ (((ob >> 9) & 1) << 5)); }
__host__ __device__ __forceinline__ void stage_rc(int b, int& R, int& C) { const int st = b / 1024, sb = b % 1024, swz = sb ^ (((sb >> 9) & 1) << 5); R = (st >> 1) * 16 + swz / 64; C = (st & 1) * 32 + (swz % 64) / 2; }
__host__ __device__ __forceinline__ int perm32(int rho) { const int n = rho >> 4, i = rho & 15; return 8 * (i >> 2) + 4 * n + (i & 3); }

struct Unit { int pm, pn; };
struct Gemm { const bf16_t* A; const bf16_t* Bt; int M, N, K; };

struct StaticOrder {
    int nM, nN, nwg, G, c;
    __host__ __device__ void init(int M, int N, int G_, int c_) { nM = M / BM; nN = N / BM; nwg = nM * nN; G = G_; c = c_; }
    __host__ __device__ bool next(int i, Unit& u) const {
        const long L = (long)i * G + c; if (L >= nwg) return false;
        int wgid = (int)L; { const int q = nwg / NXCD, r = nwg % NXCD, xcd = wgid % NXCD, off = wgid / NXCD; wgid = (xcd < r ? xcd * (q + 1) : r * (q + 1) + (xcd - r) * q) + off; }
        const int nig = WGM * nN, gid = wgid / nig, fm = gid * WGM, gsz = (nM - fm) < WGM ? (nM - fm) : WGM;
        u.pm = fm + ((wgid % nig) % gsz); u.pn = (wgid % nig) / gsz; return true;
    }
    __device__ __forceinline__ void a_ready(const Unit&) const {}
    __device__ __forceinline__ void done(const Unit&) const {}
};

__device__ __forceinline__ unsigned cvt_pk_bf16(float lo, float hi) { unsigned r; asm volatile("v_cvt_pk_bf16_f32 %0, %1, %2" : "=v"(r) : "v"(lo), "v"(hi)); return r; }
typedef float f32x2 __attribute__((ext_vector_type(2)));
__device__ __forceinline__ f32x2 gelu_pk(f32x2 v) {
    const f32x2 av = __builtin_elementwise_abs(v), d = av * 0.2316418882f + 1.0f;
    f32x2 t; t.x = __builtin_amdgcn_rcpf(d.x); t.y = __builtin_amdgcn_rcpf(d.y);
    f32x2 q = t * 0.5307027145f + (-0.7265760135f); q = q * t + 0.7107068705f; q = q * t + (-0.142248368f); q = q * t + 0.127414796f; q = q * t;
    const f32x2 s = (v * v) * (-0.72134752044f);
    f32x2 e; e.x = __builtin_amdgcn_exp2f(s.x); e.y = __builtin_amdgcn_exp2f(s.y);
    const f32x2 m = v * (q * e), r = v - m;
    f32x2 o; o.x = v.x < 0.f ? m.x : r.x; o.y = v.y < 0.f ? m.y : r.y; return o;
}

template <int ACT  > struct EpiBf16 {
    static constexpr bool PERM = true, AFTER_DRAIN = false; static_assert(ACT == 0 || ACT == 1, "EpiBf16: ACT is 0 (none) or 1 (gelu_pk)");
    bf16_t* O; int ldc; const float* bias; int split_cols; size_t split_stride; float scale0;
    __device__ __forceinline__ void operator()(const f32x4 (&acc)[2][2][4][2], const Unit& u, int wr, int wc, int fr, int fq) const {
        const int row0 = u.pm * BM + wr * 64 + fr; int colt = u.pn * BM; bf16_t* base = O;
        float sc = 1.f; if (split_cols) { const int t = colt / split_cols; base += (size_t)t * split_stride; colt -= t * split_cols; if (t == 0) sc = scale0; }
        const int col0 = colt + wc * 32 + 8 * fq, bcol0 = u.pn * BM + wc * 32 + 8 * fq;
        f32x4 bv[2][2];
#pragma unroll
        for (int bj = 0; bj < 2; ++bj)
#pragma unroll
            for (int n = 0; n < 2; ++n) bv[bj][n] = bias ? *(const f32x4*)(bias + bcol0 + bj * HALF + 4 * n) : (f32x4){0.f, 0.f, 0.f, 0.f};
#pragma unroll
        for (int ai = 0; ai < 2; ++ai)
#pragma unroll
            for (int m = 0; m < 4; ++m) { bf16_t* rowp = base + (size_t)(row0 + ai * HALF + m * 16) * ldc + col0;
#pragma unroll
                for (int bj = 0; bj < 2; ++bj) { f32x4 v0 = acc[ai][bj][m][0] + bv[bj][0], v1 = acc[ai][bj][m][1] + bv[bj][1];
                    if (ACT == 1) { f32x2 a = gelu_pk((f32x2){v0[0], v0[1]}), b = gelu_pk((f32x2){v0[2], v0[3]}), c = gelu_pk((f32x2){v1[0], v1[1]}), d = gelu_pk((f32x2){v1[2], v1[3]});
                        v0 = (f32x4){a.x, a.y, b.x, b.y}; v1 = (f32x4){c.x, c.y, d.x, d.y}; }
                    v0 = v0 * sc; v1 = v1 * sc; u32x4 w; w.x = cvt_pk_bf16(v0[0], v0[1]); w.y = cvt_pk_bf16(v0[2], v0[3]); w.z = cvt_pk_bf16(v1[0], v1[1]); w.w = cvt_pk_bf16(v1[2], v1[3]);
                    *(u32x4*)(rowp + bj * HALF) = w; } }
    }
};

template <class Epi, class Sched, bool ALIGN_EPI = false, bool SP2 = false>
__device__ __forceinline__ void gemm_phase(PG8_LAS unsigned char* lds, const Gemm g, const Sched& S, const Epi& E) {
    const int tid = threadIdx.x, wid = __builtin_amdgcn_readfirstlane(tid >> 6), lane = tid & 63, wr = wid >> 2, wc = wid & 3, fr = lane & 15, fq = lane >> 4;
    const int K = g.K, nt = K / BK;
    unsigned voffA[2], voffB[2];
#pragma unroll
    for (int i = 0; i < 2; ++i) { int R, C; stage_rc(tid * 16 + i * 8192, R, C); const int Rb = Epi::PERM ? ((R & ~31) + perm32(R & 31)) : R;
        voffA[i] = (unsigned)(R * K + C) * 2u; voffB[i] = (unsigned)(Rb * K + C) * 2u; }
    const size_t kstep = (size_t)(BK * 2);
    const size_t hstep = (size_t)HALF * K * 2;
    const size_t tstep = 2 * hstep;
    const unsigned ldsw = (unsigned)wid * 1024u;
    const int aoff = lds_byte(wr * 64 + fr, fq * 8), boff = lds_byte(wc * 32 + fr, fq * 8);
#define PG8_SA(b, h) (((b) * 2 + (h)) * HTB)
#define PG8_SB(b, h) ((4 + (b) * 2 + (h)) * HTB)
#define PG8_STAGE(bufoff, gbase, voff) do { _Pragma("unroll") for (int _i = 0; _i < 2; ++_i) \
        __builtin_amdgcn_global_load_lds((const unsigned*)((const char*)(gbase) + (voff)[_i]), (PG8_LAS unsigned*)(lds + (bufoff) + ldsw + _i * 8192), 16, 0, 0); } while (0)
#define PG8_LDA(dst, b, h) do { _Pragma("unroll") for (int m = 0; m < 4; ++m) _Pragma("unroll") for (int k = 0; k < 2; ++k) dst[m][k] = *(const PG8_LAS bf16x8*)(lds + PG8_SA(b, h) + aoff + m * 2048 + k * 1024); } while (0)
#define PG8_LDB(dst, b, h) do { _Pragma("unroll") for (int n = 0; n < 2; ++n) _Pragma("unroll") for (int k = 0; k < 2; ++k) dst[n][k] = *(const PG8_LAS bf16x8*)(lds + PG8_SB(b, h) + boff + n * 2048 + k * 1024); } while (0)
#define PG8_MMA(ai, bj, At, Bt) do { __builtin_amdgcn_s_setprio(1); _Pragma("unroll") for (int m = 0; m < 4; ++m) _Pragma("unroll") for (int n = 0; n < 2; ++n) _Pragma("unroll") for (int k = 0; k < 2; ++k) \
        acc[ai][bj][m][n] = __builtin_amdgcn_mfma_f32_16x16x32_bf16(Bt[n][k], At[m][k], acc[ai][bj][m][n], 0, 0, 0); __builtin_amdgcn_s_setprio(0); } while (0)
#define PG8_WAIT_V(n) asm volatile("s_waitcnt vmcnt(" #n ")" ::: "memory")
#define PG8_WAIT_L(n) asm volatile("s_waitcnt lgkmcnt(" #n ")" ::: "memory")
#define PG8_BAR __builtin_amdgcn_s_barrier()
#define PG8_SCHED __builtin_amdgcn_sched_barrier(0)
    Unit cur, nxt; int ui = 0;
    if (!S.next(0, cur)) return;
    f32x4 acc[2][2][4][2];
#pragma unroll
    for (int a = 0; a < 2; ++a)
#pragma unroll
        for (int b = 0; b < 2; ++b)
#pragma unroll
            for (int m = 0; m < 4; ++m)
#pragma unroll
                for (int n = 0; n < 2; ++n) acc[a][b][m][n] = (f32x4){0.f, 0.f, 0.f, 0.f};
    bf16x8 At[4][2], B0[2][2], B1[2][2];
    const char* cA = (const char*)g.A + (size_t)cur.pm * tstep; const char* cB = (const char*)g.Bt + (size_t)cur.pn * tstep;
    S.a_ready(cur);
    if constexpr (SP2) {
        PG8_STAGE(PG8_SB(0, 0), cB, voffB); PG8_STAGE(PG8_SB(0, 1), cB + hstep, voffB); PG8_STAGE(PG8_SA(0, 0), cA, voffA); PG8_STAGE(PG8_SA(0, 1), cA + hstep, voffA);
        if (wr == 1) PG8_BAR;
        PG8_WAIT_V(2); PG8_BAR;
        PG8_STAGE(PG8_SB(1, 0), cB + kstep, voffB); PG8_STAGE(PG8_SA(1, 0), cA + kstep, voffA); PG8_STAGE(PG8_SB(1, 1), cB + hstep + kstep, voffB);
        PG8_WAIT_V(6); PG8_BAR;
    } else {
        PG8_STAGE(PG8_SB(0, 0), cB, voffB); PG8_STAGE(PG8_SA(0, 0), cA, voffA); PG8_STAGE(PG8_SB(0, 1), cB + hstep, voffB); PG8_STAGE(PG8_SA(0, 1), cA + hstep, voffA);
        if (wr == 1) PG8_BAR;
        PG8_WAIT_V(4); PG8_BAR;
        PG8_STAGE(PG8_SB(1, 0), cB + kstep, voffB); PG8_STAGE(PG8_SA(1, 0), cA + kstep, voffA); PG8_STAGE(PG8_SB(1, 1), cB + hstep + kstep, voffB);
        PG8_WAIT_V(6); PG8_BAR;
    }
    for (;;) {
        const bool has_next = S.next(ui + 1, nxt);
        const char* nA = has_next ? (const char*)g.A + (size_t)nxt.pm * tstep : cA; const char* nB = has_next ? (const char*)g.Bt + (size_t)nxt.pn * tstep : cB;
        for (int t = 0; t < nt; t += 2) {
            const bool last = (t == nt - 2);
            const char* a1 = cA + (size_t)(t + 1) * kstep;
            const char* a2 = last ? nA : cA + (size_t)(t + 2) * kstep; const char* b2 = last ? nB : cB + (size_t)(t + 2) * kstep;
            const char* a3 = a2 + kstep; const char* b3 = b2 + kstep;
            if (last && has_next) S.a_ready(nxt);
            if constexpr (SP2) {
            PG8_LDB(B0, 0, 0); PG8_LDB(B1, 0, 1); PG8_SCHED; PG8_LDA(At, 0, 0); PG8_STAGE(PG8_SA(1, 1), a1 + hstep, voffA);
            PG8_WAIT_V(8); PG8_WAIT_L(0); PG8_BAR; PG8_MMA(0, 0, At, B0); PG8_MMA(0, 1, At, B1); PG8_BAR; PG8_SCHED;
            PG8_LDA(At, 0, 1); PG8_STAGE(PG8_SB(0, 0), b2, voffB); PG8_STAGE(PG8_SB(0, 1), b2 + hstep, voffB); PG8_STAGE(PG8_SA(0, 0), a2, voffA);
            PG8_WAIT_V(8); PG8_WAIT_L(0); PG8_BAR; PG8_MMA(1, 0, At, B0); PG8_MMA(1, 1, At, B1); PG8_BAR; PG8_SCHED;
            PG8_LDB(B0, 1, 0); PG8_LDB(B1, 1, 1); PG8_SCHED; PG8_LDA(At, 1, 0); PG8_STAGE(PG8_SA(0, 1), a2 + hstep, voffA);
            PG8_WAIT_V(8); PG8_WAIT_L(0); PG8_BAR; PG8_MMA(0, 0, At, B0); PG8_MMA(0, 1, At, B1); PG8_BAR; PG8_SCHED;
            PG8_LDA(At, 1, 1); PG8_STAGE(PG8_SB(1, 0), b3, voffB); PG8_STAGE(PG8_SB(1, 1), b3 + hstep, voffB); PG8_STAGE(PG8_SA(1, 0), a3, voffA);
            PG8_WAIT_V(8); PG8_WAIT_L(0); PG8_BAR; PG8_MMA(1, 0, At, B0); PG8_MMA(1, 1, At, B1); PG8_BAR; PG8_SCHED;
            } else {
            PG8_LDB(B0, 0, 0); PG8_SCHED; PG8_LDA(At, 0, 0); PG8_STAGE(PG8_SA(1, 1), a1 + hstep, voffA);
            PG8_WAIT_L(8); PG8_BAR; PG8_WAIT_L(0); PG8_MMA(0, 0, At, B0); PG8_BAR; PG8_SCHED;
            PG8_LDB(B1, 0, 1); PG8_STAGE(PG8_SB(0, 0), b2, voffB);
            PG8_BAR; PG8_WAIT_L(0); PG8_MMA(0, 1, At, B1); PG8_BAR;
            PG8_LDA(At, 0, 1); PG8_STAGE(PG8_SA(0, 0), a2, voffA);
            PG8_BAR; PG8_WAIT_L(0); PG8_MMA(1, 0, At, B0); PG8_BAR; PG8_SCHED;
            PG8_STAGE(PG8_SB(0, 1), b2 + hstep, voffB);
            PG8_WAIT_V(6); PG8_BAR; PG8_MMA(1, 1, At, B1); PG8_BAR;
            PG8_LDB(B0, 1, 0); PG8_SCHED; PG8_LDA(At, 1, 0); PG8_STAGE(PG8_SA(0, 1), a2 + hstep, voffA);
            PG8_WAIT_L(8); PG8_BAR; PG8_WAIT_L(0); PG8_MMA(0, 0, At, B0); PG8_BAR; PG8_SCHED;
            PG8_LDB(B1, 1, 1); PG8_STAGE(PG8_SB(1, 0), b3, voffB);
            PG8_BAR; PG8_WAIT_L(0); PG8_MMA(0, 1, At, B1); PG8_BAR;
            PG8_LDA(At, 1, 1); PG8_STAGE(PG8_SA(1, 0), a3, voffA);
            PG8_BAR; PG8_WAIT_L(0); PG8_MMA(1, 0, At, B0); PG8_BAR; PG8_SCHED;
            PG8_STAGE(PG8_SB(1, 1), b3 + hstep, voffB);
            PG8_WAIT_V(6); PG8_BAR; PG8_MMA(1, 1, At, B1); PG8_BAR;
            }
        }
        if constexpr (ALIGN_EPI) { if (wr == 0) PG8_BAR; }
        if constexpr (!Epi::AFTER_DRAIN) { E(acc, cur, wr, wc, fr, fq); S.done(cur); }
        if (!has_next) break;
#pragma unroll
        for (int a = 0; a < 2; ++a)
#pragma unroll
            for (int b = 0; b < 2; ++b)
#pragma unroll
                for (int m = 0; m < 4; ++m)
#pragma unroll
                    for (int n = 0; n < 2; ++n) acc[a][b][m][n] = (f32x4){0.f, 0.f, 0.f, 0.f};
        cur = nxt; cA = nA; cB = nB; ++ui;
        if constexpr (ALIGN_EPI) { if (wr == 1) PG8_BAR; }
    }
    PG8_WAIT_V(0);
    if constexpr (!ALIGN_EPI) { if (wr == 0) PG8_BAR; }
    PG8_BAR;
    if constexpr (Epi::AFTER_DRAIN) { E.fused(acc, cur, wr, wc, fr, fq, lds, wid, lane); S.done(cur); }
#undef PG8_SA
#undef PG8_SB
#undef PG8_STAGE
#undef PG8_LDA
#undef PG8_LDB
#undef PG8_MMA
#undef PG8_WAIT_V
#undef PG8_WAIT_L
#undef PG8_BAR
#undef PG8_SCHED
}
}

typedef unsigned short bf16;
typedef short bf16x8 __attribute__((ext_vector_type(8)));
typedef float f32x4 __attribute__((ext_vector_type(4)));
typedef unsigned u32x4 __attribute__((ext_vector_type(4)));
typedef unsigned u32x2 __attribute__((ext_vector_type(2)));

constexpr int SEQ = 16384, MTOK = 32768, DM = 1024, EVEN_IN = 3840, FF = 2816, QKVW = 1536;
constexpr int NTHR = 512;
constexpr size_t MiB = 1u << 20;
constexpr size_t E_WIN = 0, E_WOUT = E_WIN + 2ull * 3840 * 1024, E_WQKV = E_WOUT + 2ull * 1024 * 1024, E_WO = E_WQKV + 2ull * 1536 * 1024,
                 E_WGU = E_WO + 2ull * 1024 * 1024, E_WD = E_WGU + 4ull * 5632 * 1024, E_WL = E_WD + 4ull * 1024 * 2816, E_WEND = E_WL + 2ull * 1536 * 256;
static_assert(E_WEND * 2 <= 97 * MiB, "weights");
constexpr size_t WS_Z = 97 * MiB, WS_XN = 337 * MiB, WS_P = 401 * MiB, WS_U = 433 * MiB, WS_END = 465 * MiB;
constexpr int LDS_BYTES = 147456;

__device__ __forceinline__ float bf2f(bf16 v) { return __uint_as_float(((unsigned)v) << 16); }
__device__ __forceinline__ unsigned f2bf(float f) { unsigned u = __float_as_uint(f); return (u + 0x7fffu + ((u >> 16) & 1u)) >> 16; }
__device__ __forceinline__ unsigned pk2(float lo, float hi) { return f2bf(lo) | (f2bf(hi) << 16); }
__device__ __forceinline__ float sigmoidf_(float x) { return 1.f / (1.f + __expf(-x)); }
__device__ __forceinline__ float wave_sum(float v) {
#pragma unroll
    for (int o = 1; o < 64; o <<= 1) v += __shfl_xor(v, o);
    return v;
}
__device__ __forceinline__ float red16(float v) { v += __shfl_xor(v, 1); v += __shfl_xor(v, 2); v += __shfl_xor(v, 4); v += __shfl_xor(v, 8); return v; }
__device__ __forceinline__ float max16(float v) { v = fmaxf(v, __shfl_xor(v, 1)); v = fmaxf(v, __shfl_xor(v, 2)); v = fmaxf(v, __shfl_xor(v, 4)); v = fmaxf(v, __shfl_xor(v, 8)); return v; }

__device__ __forceinline__ f32x4 mma16(const bf16* A, int lda, int r0, const bf16* Bt, int ldb, int c0, int k0, f32x4 acc, int lane) {
    const int r = lane & 15, q = lane >> 4;
    const bf16x8 a = *(const bf16x8*)(A + (r0 + r) * lda + k0 + q * 8);
    const bf16x8 b = *(const bf16x8*)(Bt + (c0 + r) * ldb + k0 + q * 8);
    return __builtin_amdgcn_mfma_f32_16x16x32_bf16(a, b, acc, 0, 0, 0);
}

struct Params {
    const float *x, *norm1_g, *norm2_g, *final_g, *even_w_in, *even_w_out, *rwkv_mu, *rwkv_w0, *rwkv_w_up, *rwkv_a0, *rwkv_a_up, *rwkv_g_up,
                *rwkv_k_k, *rwkv_k_a, *rwkv_r_k, *rwkv_ln_g, *rwkv_ln_b, *swa_w_qkv, *swa_b_qkv, *swa_sinks, *swa_w_o, *swa_b_o, *ffn_w_gate, *ffn_w_up, *ffn_w_down;
    float* out; unsigned char* ws;
};

struct EpiStore {
    static constexpr bool PERM = true, AFTER_DRAIN = false;
    bf16* O; int ldc; const float* bias;
    __device__ __forceinline__ void operator()(const pg8::f32x4 (&acc)[2][2][4][2], const pg8::Unit& u, int wr, int wc, int fr, int fq) const {
        const int row0 = u.pm * 256 + wr * 64 + fr, col0 = u.pn * 256 + wc * 32 + 8 * fq;
        f32x4 bv[2][2];
#pragma unroll
        for (int bj = 0; bj < 2; ++bj)
#pragma unroll
            for (int n = 0; n < 2; ++n) bv[bj][n] = bias ? *(const f32x4*)(bias + col0 + bj * 128 + 4 * n) : (f32x4){0.f, 0.f, 0.f, 0.f};
#pragma unroll
        for (int ai = 0; ai < 2; ++ai)
#pragma unroll
            for (int m = 0; m < 4; ++m) { bf16* rowp = O + (size_t)(row0 + ai * 128 + m * 16) * ldc + col0;
#pragma unroll
                for (int bj = 0; bj < 2; ++bj) { const f32x4 v0 = acc[ai][bj][m][0] + bv[bj][0], v1 = acc[ai][bj][m][1] + bv[bj][1];
                    u32x4 w; w.x = pk2(v0[0], v0[1]); w.y = pk2(v0[2], v0[3]); w.z = pk2(v1[0], v1[1]); w.w = pk2(v1[2], v1[3]);
                    *(u32x4*)(rowp + bj * 128) = w; } }
    }
};
struct EpiRes {
    static constexpr bool PERM = false, AFTER_DRAIN = false;
    float* H; int ldc; const float* bias;
    __device__ __forceinline__ void operator()(const pg8::f32x4 (&acc)[2][2][4][2], const pg8::Unit& u, int wr, int wc, int fr, int fq) const {
        const int col0 = u.pn * 256 + wc * 32 + 4 * fq;
#pragma unroll
        for (int ai = 0; ai < 2; ++ai)
#pragma unroll
            for (int m = 0; m < 4; ++m) { const int r = u.pm * 256 + ai * 128 + wr * 64 + m * 16 + fr; float* rowp = H + (size_t)r * ldc + col0;
#pragma unroll
                for (int bj = 0; bj < 2; ++bj)
#pragma unroll
                    for (int n = 0; n < 2; ++n) { float* p = rowp + bj * 128 + n * 16; f32x4 o = *(const f32x4*)p + acc[ai][bj][m][n];
                        if (bias) o = o + *(const f32x4*)(bias + col0 + bj * 128 + n * 16);
                        *(f32x4*)p = o; } }
    }
};
struct EpiSwiglu {
    static constexpr bool PERM = true, AFTER_DRAIN = false;
    bf16* O; int ldc;
    __device__ __forceinline__ void operator()(const pg8::f32x4 (&acc)[2][2][4][2], const pg8::Unit& u, int wr, int wc, int fr, int fq) const {
        const int row0 = u.pm * 256 + wr * 64 + fr, col0 = u.pn * 128 + wc * 32 + 8 * fq;
#pragma unroll
        for (int ai = 0; ai < 2; ++ai)
#pragma unroll
            for (int m = 0; m < 4; ++m) { bf16* rowp = O + (size_t)(row0 + ai * 128 + m * 16) * ldc + col0;
                float v[8];
#pragma unroll
                for (int n = 0; n < 2; ++n)
#pragma unroll
                    for (int x = 0; x < 4; ++x) { const float g = acc[ai][0][m][n][x], up = acc[ai][1][m][n][x]; v[4 * n + x] = g * sigmoidf_(g) * up; }
                u32x4 w; w.x = pk2(v[0], v[1]); w.y = pk2(v[2], v[3]); w.z = pk2(v[4], v[5]); w.w = pk2(v[6], v[7]);
                *(u32x4*)rowp = w; }
    }
};
struct EpiLora {
    static constexpr bool PERM = true, AFTER_DRAIN = false;
    bf16* Z; const float* w0; const float* a0;
    __device__ __forceinline__ void operator()(const pg8::f32x4 (&acc)[2][2][4][2], const pg8::Unit& u, int wr, int wc, int fr, int fq) const {
        const int row0 = u.pm * 256 + wr * 64 + fr;
#pragma unroll
        for (int bj = 0; bj < 2; ++bj) {
            const int col = u.pn * 256 + bj * 128 + wc * 32 + 8 * fq;
            float bb[8];
#pragma unroll
            for (int x = 0; x < 8; ++x) bb[x] = col < 512 ? w0[col + x] : (col < 1024 ? a0[col - 512 + x] : 0.f);
#pragma unroll
            for (int ai = 0; ai < 2; ++ai)
#pragma unroll
                for (int m = 0; m < 4; ++m) { bf16* zrow = Z + (size_t)(row0 + ai * 128 + m * 16) * EVEN_IN;
                    float v[8];
#pragma unroll
                    for (int n = 0; n < 2; ++n)
#pragma unroll
                        for (int x = 0; x < 4; ++x) v[4 * n + x] = acc[ai][bj][m][n][x] + bb[4 * n + x];
                    if (col < 512) {
                        float* fp = (float*)zrow + col; *(f32x4*)fp = (f32x4){v[0], v[1], v[2], v[3]}; *(f32x4*)(fp + 4) = (f32x4){v[4], v[5], v[6], v[7]};
                    } else {
                        u32x4 w; w.x = pk2(v[0], v[1]); w.y = pk2(v[2], v[3]); w.z = pk2(v[4], v[5]); w.w = pk2(v[6], v[7]);
                        *(u32x4*)(zrow + 512 + col) = w;
                    } }
        }
    }
};
template <class Epi>
__device__ __forceinline__ void run_gemm(unsigned char* lds, const bf16* A, const bf16* Bt, int M, int N, int K, const Epi& E) {
    pg8::Gemm g{A, Bt, M, N, K}; pg8::StaticOrder S; S.init(M, N, (int)gridDim.x, (int)blockIdx.x);
    pg8::gemm_phase<Epi, pg8::StaticOrder, true, true>((PG8_LAS unsigned char*)lds, g, S, E);
}

__device__ __forceinline__ void tr_item(const float* W, int K, int N, bf16* WT, int mode, float* scr, int item, int lane) {
    const int nblk = N / 32, kb = item / nblk, nb = item % nblk, k0 = 64 * kb, n0 = 32 * nb;
#pragma unroll 8
    for (int i = 0; i < 32; ++i) { const int kk = 2 * i + (lane >> 5); scr[kk * 33 + (lane & 31)] = W[(size_t)(k0 + kk) * N + n0 + (lane & 31)]; }
    asm volatile("s_waitcnt lgkmcnt(0)" ::: "memory");
    const int c = lane & 7;
    const int d0 = mode == 0 ? n0 : ((n0 >> 7) * 256 + (n0 & 127) + (mode == 2 ? 128 : 0));
#pragma unroll
    for (int j = 0; j < 4; ++j) { const int n = (lane >> 3) + 8 * j; const float* s = scr + (8 * c) * 33 + n;
        u32x4 o; o.x = pk2(s[0 * 33], s[1 * 33]); o.y = pk2(s[2 * 33], s[3 * 33]); o.z = pk2(s[4 * 33], s[5 * 33]); o.w = pk2(s[6 * 33], s[7 * 33]);
        *(u32x4*)(WT + (size_t)(d0 + n) * K + k0 + 8 * c) = o; }
    asm volatile("s_waitcnt lgkmcnt(0)" ::: "memory");
}
__device__ __forceinline__ void tr_matrix(const float* W, int K, int N, bf16* WT, int mode, float* scr, int gw, int ngw, int lane) {
    const int nitems = (K / 64) * (N / 32);
    for (int it = gw; it < nitems; it += ngw) tr_item(W, K, N, WT, mode, scr, it, lane);
}
__device__ __forceinline__ void weights_phase(const Params& p, unsigned char* lds) {
    const int tid = threadIdx.x, lane = tid & 63, wave = tid >> 6;
    float* scr = (float*)(lds + wave * 16384);
    const int gw = blockIdx.x * 8 + wave, ngw = gridDim.x * 8;
    bf16* wb = (bf16*)p.ws;
    for (int l = 0; l < 2; ++l) {
        tr_matrix(p.even_w_in + (size_t)l * 1024 * 3840, 1024, 3840, wb + E_WIN + (size_t)l * 3840 * 1024, 0, scr, gw, ngw, lane);
        tr_matrix(p.even_w_out + (size_t)l * 1024 * 1024, 1024, 1024, wb + E_WOUT + (size_t)l * 1024 * 1024, 0, scr, gw, ngw, lane);
        tr_matrix(p.swa_w_qkv + (size_t)l * 1024 * 1536, 1024, 1536, wb + E_WQKV + (size_t)l * 1536 * 1024, 0, scr, gw, ngw, lane);
        tr_matrix(p.swa_w_o + (size_t)l * 1024 * 1024, 1024, 1024, wb + E_WO + (size_t)l * 1024 * 1024, 0, scr, gw, ngw, lane);
    }
    for (int l = 0; l < 4; ++l) {
        tr_matrix(p.ffn_w_gate + (size_t)l * 1024 * FF, 1024, FF, wb + E_WGU + (size_t)l * 5632 * 1024, 1, scr, gw, ngw, lane);
        tr_matrix(p.ffn_w_up + (size_t)l * 1024 * FF, 1024, FF, wb + E_WGU + (size_t)l * 5632 * 1024, 2, scr, gw, ngw, lane);
        tr_matrix(p.ffn_w_down + (size_t)l * FF * 1024, FF, 1024, wb + E_WD + (size_t)l * 1024 * FF, 0, scr, gw, ngw, lane);
    }
    const int gt = blockIdx.x * NTHR + tid, ngt = gridDim.x * NTHR;
    for (int idx = gt; idx < 2 * 1536 * 256; idx += ngt) {
        const int l = idx / (1536 * 256), r = idx % (1536 * 256), n = r >> 8, k = r & 255; float v = 0.f;
        if (n < 512) { if (k < 64) v = p.rwkv_w_up[(size_t)l * 64 * 512 + k * 512 + n]; }
        else if (n < 1024) { if (k >= 64 && k < 128) v = p.rwkv_a_up[(size_t)l * 64 * 512 + (k - 64) * 512 + (n - 512)]; }
        else { if (k >= 128) v = p.rwkv_g_up[(size_t)l * 128 * 512 + (k - 128) * 512 + (n - 1024)]; }
        wb[E_WL + idx] = (bf16)f2bf(v);
    }
}
__device__ __forceinline__ void rms_phase(const float* src, float* hcopy, const float* g, bf16* xn, float* outf) {
    const int tid = threadIdx.x, lane = tid & 63, wave = tid >> 6;
    const int gw = blockIdx.x * 8 + wave, ngw = gridDim.x * 8;
    f32x4 gv[4];
#pragma unroll
    for (int j = 0; j < 4; ++j) gv[j] = ((const f32x4*)g)[lane + 64 * j];
    for (int m = gw; m < MTOK; m += ngw) {
        const f32x4* xr = (const f32x4*)(src + (size_t)m * DM) + lane;
        f32x4 v[4]; float s = 0.f;
#pragma unroll
        for (int j = 0; j < 4; ++j) { v[j] = xr[64 * j]; s += (v[j][0] * v[j][0] + v[j][1] * v[j][1]) + (v[j][2] * v[j][2] + v[j][3] * v[j][3]); }
        const float rstd = rsqrtf(wave_sum(s) * (1.f / DM) + 1e-6f);
        if (hcopy) {
#pragma unroll
            for (int j = 0; j < 4; ++j) ((f32x4*)(hcopy + (size_t)m * DM))[lane + 64 * j] = v[j];
        }
#pragma unroll
        for (int j = 0; j < 4; ++j) { const f32x4 y = v[j] * rstd * gv[j];
            if (xn) { u32x2 w; w.x = pk2(y[0], y[1]); w.y = pk2(y[2], y[3]); ((u32x2*)(xn + (size_t)m * DM))[lane + 64 * j] = w; }
            if (outf) ((f32x4*)(outf + (size_t)m * DM))[lane + 64 * j] = y; }
    }
}
__device__ __forceinline__ void prepA_phase(const bf16* Z, const float* mu, bf16* AL) {
    const int gt = blockIdx.x * NTHR + threadIdx.x, ngt = gridDim.x * NTHR;
    for (int idx = gt; idx < MTOK * 128; idx += ngt) {
        const int row = idx >> 7, c = (idx & 127) * 2, t = row & (SEQ - 1);
        const unsigned cur = *(const unsigned*)(Z + (size_t)row * EVEN_IN + 3584 + c);
        const unsigned prv = t > 0 ? *(const unsigned*)(Z + (size_t)(row - 1) * EVEN_IN + 3584 + c) : 0u;
        float o[2];
#pragma unroll
        for (int x = 0; x < 2; ++x) { const float zc = bf2f((bf16)(cur >> (16 * x))), zp = bf2f((bf16)(prv >> (16 * x)));
            const float zs = zc + mu[1536 + c + x] * (zp - zc);
            o[x] = (c < 64) ? tanhf(zs) : ((c < 128) ? zs : sigmoidf_(zs)); }
        *(unsigned*)(AL + (size_t)row * 256 + c) = pk2(o[0], o[1]);
    }
}

__device__ __forceinline__ float rope_inv_freq(int p) { return exp2f(-(float)p * (13.287712379549449f / 31.0f)); }
__device__ __forceinline__ void ret_kv_phase(const bf16* Z, float* KV, unsigned char* lds) {
    bf16* Kt = (bf16*)lds; bf16* Vt = (bf16*)(lds + 17408);
    const int tid = threadIdx.x, lane = tid & 63, wave = tid >> 6, r16 = lane & 15, q4 = lane >> 4;
    const float invf = rope_inv_freq(tid & 31);
    for (int u = blockIdx.x; u < 2048; u += gridDim.x) {
        const int b = u >> 10, h = (u >> 7) & 7, n = u & 127; const size_t rowbase = (size_t)b * SEQ + n * 128;
        const float lg = log1pf(-exp2f(-5.f - (float)h));
        __syncthreads();
        for (int idx = tid; idx < 4096; idx += NTHR) { const int pp = idx & 31, i = idx >> 5;
            const bf16* zr = Z + (rowbase + i) * EVEN_IN + 512 + h * 64; const float x1 = bf2f(zr[pp]), x2 = bf2f(zr[pp + 32]);
            const float ang = (float)(n * 128 + i) * invf; const float sn = sinf(ang), cs = cosf(ang);
            const float sc = 0.125f * __expf((float)(127 - i) * lg);
            Kt[pp * 136 + i] = (bf16)f2bf((x1 * cs - x2 * sn) * sc); Kt[(pp + 32) * 136 + i] = (bf16)f2bf((x1 * sn + x2 * cs) * sc); }
        for (int ci = tid; ci < 1024; ci += NTHR) { const int j = ci >> 3, c8 = (ci & 7) * 8;
            const u32x4 vv = *(const u32x4*)(Z + (rowbase + j) * EVEN_IN + 1024 + h * 64 + c8);
#pragma unroll
            for (int x = 0; x < 8; ++x) Vt[(c8 + x) * 136 + j] = (bf16)(vv[x >> 1] >> (16 * (x & 1))); }
        __syncthreads();
        const int dtile = wave >> 1;
#pragma unroll
        for (int e2 = 0; e2 < 2; ++e2) { const int etile = (wave & 1) * 2 + e2; f32x4 acc = {0.f, 0.f, 0.f, 0.f};
#pragma unroll
            for (int k0 = 0; k0 < 128; k0 += 32) acc = mma16(Kt, 136, 16 * dtile, Vt, 136, 16 * etile, k0, acc, lane);
#pragma unroll
            for (int jj = 0; jj < 4; ++jj) KV[((size_t)u * 64 + 16 * dtile + q4 * 4 + jj) * 64 + 16 * etile + r16] = acc[jj]; }
    }
}
__device__ __forceinline__ void ret_scan_phase(float* KV) {
    const int gt = blockIdx.x * NTHR + threadIdx.x, ngt = gridDim.x * NTHR;
    for (int e = gt; e < 65536; e += ngt) {
        const int bh = e >> 12, de = e & 4095, h = bh & 7;
        const float cd = expf(128.f * log1pf(-exp2f(-5.f - (float)h)));
        float st = 0.f; float* ptr = KV + (size_t)bh * 128 * 4096 + de;
        for (int n = 0; n < 128; ++n) { const float kv = ptr[(size_t)n * 4096]; ptr[(size_t)n * 4096] = st; st = cd * st + kv; }
    }
}
__device__ __forceinline__ void ret_out_phase(const bf16* Z, const float* KV, bf16* MIX, unsigned char* lds) {
    bf16* Qs = (bf16*)lds; bf16* Ks = (bf16*)(lds + 18432); bf16* Vt = (bf16*)(lds + 36864); bf16* St = (bf16*)(lds + 54272); bf16* Ps = (bf16*)(lds + 63488);
    const int tid = threadIdx.x, lane = tid & 63, wave = tid >> 6, r16 = lane & 15, q4 = lane >> 4;
    const float invf = rope_inv_freq(tid & 31);
    for (int u = blockIdx.x; u < 2048; u += gridDim.x) {
        const int b = u >> 10, h = (u >> 7) & 7, n = u & 127; const size_t rowbase = (size_t)b * SEQ + n * 128;
        const float lg = log1pf(-exp2f(-5.f - (float)h));
        __syncthreads();
        for (int idx = tid; idx < 4096; idx += NTHR) { const int pp = idx & 31, i = idx >> 5;
            const bf16* zq = Z + (rowbase + i) * EVEN_IN + h * 64; const bf16* zk = zq + 512;
            const float ang = (float)(n * 128 + i) * invf; const float sn = sinf(ang), cs = cosf(ang);
            float x1 = bf2f(zq[pp]), x2 = bf2f(zq[pp + 32]);
            Qs[i * 72 + pp] = (bf16)f2bf(x1 * cs - x2 * sn); Qs[i * 72 + pp + 32] = (bf16)f2bf(x1 * sn + x2 * cs);
            x1 = bf2f(zk[pp]); x2 = bf2f(zk[pp + 32]);
            Ks[i * 72 + pp] = (bf16)f2bf((x1 * cs - x2 * sn) * 0.125f); Ks[i * 72 + pp + 32] = (bf16)f2bf((x1 * sn + x2 * cs) * 0.125f); }
        for (int ci = tid; ci < 1024; ci += NTHR) { const int j = ci >> 3, c8 = (ci & 7) * 8;
            const u32x4 vv = *(const u32x4*)(Z + (rowbase + j) * EVEN_IN + 1024 + h * 64 + c8);
#pragma unroll
            for (int x = 0; x < 8; ++x) Vt[(c8 + x) * 136 + j] = (bf16)(vv[x >> 1] >> (16 * (x & 1))); }
        for (int idx = tid; idx < 4096; idx += NTHR) { const int d = idx >> 6, e = idx & 63; St[e * 72 + d] = (bf16)f2bf(KV[(size_t)u * 4096 + idx]); }
        __syncthreads();
        f32x4 acc[8];
#pragma unroll
        for (int kt = 0; kt < 8; ++kt) { acc[kt] = (f32x4){0.f, 0.f, 0.f, 0.f};
#pragma unroll
            for (int k0 = 0; k0 < 64; k0 += 32) acc[kt] = mma16(Qs, 72, 16 * wave, Ks, 72, 16 * kt, k0, acc[kt], lane); }
#pragma unroll
        for (int kt = 0; kt < 8; ++kt)
#pragma unroll
            for (int jj = 0; jj < 4; ++jj) { const int i = 16 * wave + q4 * 4 + jj, j = 16 * kt + r16;
                const float val = (i >= j) ? acc[kt][jj] * __expf((float)(i - j) * lg) : 0.f;
                Ps[i * 136 + j] = (bf16)f2bf(val); }
        __syncthreads();
        f32x4 o[4], o2[4];
#pragma unroll
        for (int dt = 0; dt < 4; ++dt) { o[dt] = (f32x4){0.f, 0.f, 0.f, 0.f}; o2[dt] = (f32x4){0.f, 0.f, 0.f, 0.f};
#pragma unroll
            for (int k0 = 0; k0 < 128; k0 += 32) o[dt] = mma16(Ps, 136, 16 * wave, Vt, 136, 16 * dt, k0, o[dt], lane);
#pragma unroll
            for (int k0 = 0; k0 < 64; k0 += 32) o2[dt] = mma16(Qs, 72, 16 * wave, St, 72, 16 * dt, k0, o2[dt], lane); }
#pragma unroll
        for (int jj = 0; jj < 4; ++jj) { const int i = 16 * wave + q4 * 4 + jj; const float qd = __expf((float)(i + 1) * lg);
            float v[4]; float s = 0.f;
#pragma unroll
            for (int dt = 0; dt < 4; ++dt) { v[dt] = o[dt][jj] + qd * o2[dt][jj]; s += v[dt]; }
            const float mean = red16(s) * (1.f / 64.f); float q = 0.f;
#pragma unroll
            for (int dt = 0; dt < 4; ++dt) { v[dt] -= mean; q += v[dt] * v[dt]; }
            const float rstd = rsqrtf(red16(q) * (1.f / 64.f) + 1e-6f);
#pragma unroll
            for (int dt = 0; dt < 4; ++dt) { const int e = 16 * dt + r16; const float g = bf2f(Z[(rowbase + i) * EVEN_IN + 1536 + h * 64 + e]);
                MIX[(rowbase + i) * DM + h * 64 + e] = (bf16)f2bf(v[dt] * rstd * g * sigmoidf_(g)); } }
    }
}

__device__ __forceinline__ void swa_phase(const bf16* QKV, bf16* MIX, const float* sinks, unsigned char* lds) {
    bf16* Ks = (bf16*)lds; bf16* Vt = (bf16*)(lds + 36864); bf16* Qs = (bf16*)(lds + 70656); bf16* Ps = (bf16*)(lds + 89088);
    const int tid = threadIdx.x, lane = tid & 63, wave = tid >> 6, r16 = lane & 15, q4 = lane >> 4;
    for (int u = blockIdx.x; u < 1024; u += gridDim.x) {
        const int b = u >> 9, kvh = (u >> 7) & 3, n = u & 127; const size_t rowbase = (size_t)b * SEQ + n * 128;
        __syncthreads();
        for (int ci = tid; ci < 2048; ci += NTHR) { const int kj = ci >> 3, c8 = (ci & 7) * 8; const bool ok = (n > 0) || (kj >= 128);
            u32x4 kv = {0u, 0u, 0u, 0u}, vv = {0u, 0u, 0u, 0u};
            if (ok) { const bf16* src = QKV + (rowbase - 128 + kj) * QKVW + kvh * 64 + c8; kv = *(const u32x4*)(src + 1024); vv = *(const u32x4*)(src + 1280); }
            *(u32x4*)(Ks + kj * 72 + c8) = kv;
#pragma unroll
            for (int x = 0; x < 8; ++x) Vt[(c8 + x) * 264 + kj] = (bf16)(vv[x >> 1] >> (16 * (x & 1))); }
        for (int g = 0; g < 4; ++g) {
            const int hq = kvh * 4 + g;
            __syncthreads();
            for (int ci = tid; ci < 1024; ci += NTHR) { const int qi = ci >> 3, c8 = (ci & 7) * 8; *(u32x4*)(Qs + qi * 72 + c8) = *(const u32x4*)(QKV + (rowbase + qi) * QKVW + hq * 64 + c8); }
            __syncthreads();
            f32x4 acc[16];
#pragma unroll
            for (int kt = 0; kt < 16; ++kt) { acc[kt] = (f32x4){0.f, 0.f, 0.f, 0.f};
#pragma unroll
                for (int k0 = 0; k0 < 64; k0 += 32) acc[kt] = mma16(Qs, 72, 16 * wave, Ks, 72, 16 * kt, k0, acc[kt], lane); }
            const float sink = sinks[hq];
            float mx[4] = {-INFINITY, -INFINITY, -INFINITY, -INFINITY};
#pragma unroll
            for (int kt = 0; kt < 16; ++kt)
#pragma unroll
                for (int jj = 0; jj < 4; ++jj) { const int qi = 16 * wave + q4 * 4 + jj, kj = 16 * kt + r16, rel = qi + 128 - kj;
                    const bool valid = (rel >= 0) && (rel < 128) && ((n > 0) || (kj >= 128));
                    const float s = valid ? acc[kt][jj] * 0.125f : -INFINITY; acc[kt][jj] = s; mx[jj] = fmaxf(mx[jj], s); }
            float sum[4];
#pragma unroll
            for (int jj = 0; jj < 4; ++jj) { mx[jj] = fmaxf(max16(mx[jj]), sink); sum[jj] = 0.f; }
#pragma unroll
            for (int kt = 0; kt < 16; ++kt)
#pragma unroll
                for (int jj = 0; jj < 4; ++jj) { const float e = __expf(acc[kt][jj] - mx[jj]); acc[kt][jj] = e; sum[jj] += e; }
#pragma unroll
            for (int jj = 0; jj < 4; ++jj) sum[jj] = red16(sum[jj]) + __expf(sink - mx[jj]);
            f32x4 o[4];
#pragma unroll
            for (int dt = 0; dt < 4; ++dt) o[dt] = (f32x4){0.f, 0.f, 0.f, 0.f};
#pragma unroll
            for (int half = 0; half < 2; ++half) {
                __syncthreads();
#pragma unroll
                for (int k8 = 0; k8 < 8; ++k8)
#pragma unroll
                    for (int jj = 0; jj < 4; ++jj) Ps[(16 * wave + q4 * 4 + jj) * 136 + k8 * 16 + r16] = (bf16)f2bf(acc[half * 8 + k8][jj]);
                __syncthreads();
#pragma unroll
                for (int dt = 0; dt < 4; ++dt)
#pragma unroll
                    for (int k0 = 0; k0 < 128; k0 += 32) o[dt] = mma16(Ps, 136, 16 * wave, Vt + half * 128, 264, 16 * dt, k0, o[dt], lane);
            }
#pragma unroll
            for (int jj = 0; jj < 4; ++jj) { const float inv = 1.f / sum[jj]; const size_t row = rowbase + 16 * wave + q4 * 4 + jj;
#pragma unroll
                for (int dt = 0; dt < 4; ++dt) MIX[row * DM + hq * 64 + 16 * dt + r16] = (bf16)f2bf(o[dt][jj] * inv); }
        }
    }
}

struct RwkvW { const float *mu, *k_k, *k_a, *r_k, *ln_g, *ln_b; };
template <int PASS>
__device__ __forceinline__ void rwkv_scan_phase(const bf16* Z, const RwkvW w, float* Pb, float* Ub, bf16* MIX, unsigned char* lds) {
    constexpr int NSL = (PASS == 1) ? 4 : 8, CPL = 64 / NSL;
    float* opA = (float*)lds; float* opB = opA + 2048; float* opW = opB + 2048; float* opK = opW + 2048; float* opV = opK + 2048; float* opR = opV + 2048; float* ybuf = opR + 2048;
    const int tid = threadIdx.x;
    const int row = tid / NSL, sl = tid % NSL, j0 = sl * CPL;
    for (int u = blockIdx.x; u < 2048; u += gridDim.x) {
        const int bh = u >> 7, c = u & 127, b = bh >> 3, h = bh & 7;
        float S[CPL];
        if (PASS == 1) {
#pragma unroll
            for (int x = 0; x < CPL; ++x) S[x] = (row >= 64 && (row - 64) == (j0 + x)) ? 1.f : 0.f;
        } else {
            if (c == 0) {
#pragma unroll
                for (int x = 0; x < CPL; ++x) S[x] = 0.f;
            } else { const float* sp = Ub + ((size_t)(u - 1) * 64 + row) * 64 + j0;
#pragma unroll
                for (int x = 0; x < CPL; x += 4) { const f32x4 t4 = *(const f32x4*)(sp + x); S[x] = t4[0]; S[x + 1] = t4[1]; S[x + 2] = t4[2]; S[x + 3] = t4[3]; } }
        }
        for (int sub = 0; sub < 4; ++sub) {
            __syncthreads();
            {
                const int tt = tid >> 4, jg = (tid & 15) * 4, t = c * 128 + sub * 32 + tt, col = h * 64 + jg; const size_t grow = (size_t)b * SEQ + t;
                const bf16* zc = Z + grow * EVEN_IN; const bf16* zp = zc - EVEN_IN; const bool hp = t > 0;
                const u32x2 cr = *(const u32x2*)(zc + 2048 + col), ck = *(const u32x2*)(zc + 2560 + col), cv = *(const u32x2*)(zc + 3072 + col);
                u32x2 pr = {0u, 0u}, pk = {0u, 0u}, pv = {0u, 0u};
                if (hp) { pr = *(const u32x2*)(zp + 2048 + col); pk = *(const u32x2*)(zp + 2560 + col); pv = *(const u32x2*)(zp + 3072 + col); }
                const f32x4 dec = *(const f32x4*)((const float*)zc + col);
                const u32x2 av = *(const u32x2*)(zc + 1024 + col);
                float r4[4], k4[4], v4[4], a4[4], kk[4]; float ss = 0.f;
#pragma unroll
                for (int x = 0; x < 4; ++x) { const int sh = 16 * (x & 1); const int wi = x >> 1;
                    const float zr = bf2f((bf16)(cr[wi] >> sh)), zk = bf2f((bf16)(ck[wi] >> sh)), zv = bf2f((bf16)(cv[wi] >> sh));
                    const float qr = bf2f((bf16)(pr[wi] >> sh)), qk = bf2f((bf16)(pk[wi] >> sh)), qv = bf2f((bf16)(pv[wi] >> sh));
                    r4[x] = zr + w.mu[col + x] * (qr - zr); k4[x] = zk + w.mu[512 + col + x] * (qk - zk); v4[x] = zv + w.mu[1024 + col + x] * (qv - zv);
                    a4[x] = sigmoidf_(bf2f((bf16)(av[wi] >> sh)));
                    kk[x] = k4[x] * w.k_k[col + x]; ss += kk[x] * kk[x]; }
                ss = red16(ss);
                const float inv = 1.f / fmaxf(sqrtf(ss), 1e-12f);
                f32x4 oA, oB, oW, oK, oV, oR;
#pragma unroll
                for (int x = 0; x < 4; ++x) { const float kn = kk[x] * inv; oA[x] = -kn; oB[x] = kn * a4[x]; { const float uu = dec[x]; const float sp = fmaxf(-uu, 0.f) + log1pf(__expf(-fabsf(uu))); oW[x] = __expf(-__expf(-sp - 0.5f)); } oK[x] = k4[x] * (1.f + (a4[x] - 1.f) * w.k_a[col + x]); oV[x] = v4[x]; oR[x] = r4[x]; }
                const int o = tt * 64 + jg;
                *(f32x4*)(opA + o) = oA; *(f32x4*)(opB + o) = oB; *(f32x4*)(opW + o) = oW; *(f32x4*)(opK + o) = oK; *(f32x4*)(opV + o) = oV; *(f32x4*)(opR + o) = oR;
            }
            __syncthreads();
#pragma unroll 2
            for (int tt = 0; tt < 32; ++tt) {
                const float* pa = opA + tt * 64 + j0; const float* pb = opB + tt * 64 + j0; const float* pw = opW + tt * 64 + j0; const float* pk = opK + tt * 64 + j0;
                float a_[CPL], b_[CPL], w_[CPL], k_[CPL];
#pragma unroll
                for (int x = 0; x < CPL; x += 4) { const f32x4 ta = *(const f32x4*)(pa + x), tb = *(const f32x4*)(pb + x), tw = *(const f32x4*)(pw + x), tk = *(const f32x4*)(pk + x);
#pragma unroll
                    for (int y = 0; y < 4; ++y) { a_[x + y] = ta[y]; b_[x + y] = tb[y]; w_[x + y] = tw[y]; k_[x + y] = tk[y]; } }
                float sa0 = 0.f, sa1 = 0.f;
#pragma unroll
                for (int x = 0; x < CPL; x += 2) { sa0 += S[x] * a_[x]; sa1 += S[x + 1] * a_[x + 1]; }
                float sa = sa0 + sa1;
                sa += __shfl_xor(sa, 1); sa += __shfl_xor(sa, 2); if (NSL == 8) sa += __shfl_xor(sa, 4);
                const float vi = (PASS == 1) ? ((row < 64) ? opV[tt * 64 + row] : 0.f) : opV[tt * 64 + row];
#pragma unroll
                for (int x = 0; x < CPL; ++x) S[x] = S[x] * w_[x] + (sa * b_[x] + vi * k_[x]);
                if (PASS == 3) {
                    const float* prr = opR + tt * 64 + j0; float y0 = 0.f, y1 = 0.f;
#pragma unroll
                    for (int x = 0; x < CPL; x += 4) { const f32x4 tr = *(const f32x4*)(prr + x); y0 += S[x] * tr[0] + S[x + 2] * tr[2]; y1 += S[x + 1] * tr[1] + S[x + 3] * tr[3]; }
                    float y = y0 + y1;
                    y += __shfl_xor(y, 1); y += __shfl_xor(y, 2); y += __shfl_xor(y, 4);
                    if (sl == 0) ybuf[tt * 64 + row] = y;
                }
            }
            if (PASS == 3) {
                __syncthreads();
                const int tt = tid >> 4, ig = (tid & 15) * 4, t = c * 128 + sub * 32 + tt, col = h * 64 + ig; const size_t grow = (size_t)b * SEQ + t;
                const f32x4 y4 = *(const f32x4*)(ybuf + tt * 64 + ig), r4 = *(const f32x4*)(opR + tt * 64 + ig), k4 = *(const f32x4*)(opK + tt * 64 + ig), v4 = *(const f32x4*)(opV + tt * 64 + ig);
                const float mean = red16((y4[0] + y4[1]) + (y4[2] + y4[3])) * (1.f / 64.f);
                float q = 0.f, dot = 0.f;
#pragma unroll
                for (int x = 0; x < 4; ++x) { const float d = y4[x] - mean; q += d * d; dot += r4[x] * k4[x] * w.r_k[col + x]; }
                const float rstd = rsqrtf(red16(q) * (1.f / 64.f) + 64e-5f); dot = red16(dot);
                const u32x2 gv = *(const u32x2*)(Z + grow * EVEN_IN + 1536 + col);
                float o4[4];
#pragma unroll
                for (int x = 0; x < 4; ++x) { const float gate = bf2f((bf16)(gv[x >> 1] >> (16 * (x & 1))));
                    o4[x] = ((y4[x] - mean) * rstd * w.ln_g[col + x] + w.ln_b[col + x] + dot * v4[x]) * gate; }
                u32x2 ow; ow.x = pk2(o4[0], o4[1]); ow.y = pk2(o4[2], o4[3]);
                *(u32x2*)(MIX + grow * DM + 512 + col) = ow;
            }
        }
        if (PASS == 1) { float* dst = (row < 64) ? (Ub + ((size_t)u * 64 + row) * 64 + j0) : (Pb + ((size_t)u * 64 + (row - 64)) * 64 + j0);
#pragma unroll
            for (int x = 0; x < CPL; x += 4) *(f32x4*)(dst + x) = (f32x4){S[x], S[x + 1], S[x + 2], S[x + 3]}; }
    }
}
__device__ __forceinline__ void rwkv_combine_phase(const float* Pb, float* Ub, unsigned char* lds) {
    float* s = (float*)lds; float* red = s + 256;
    const int tid = threadIdx.x, j = tid & 63, kq = tid >> 6;
    for (int item = blockIdx.x; item < 256; item += gridDim.x) {
        const int bh = item >> 4, rg = item & 15;
        __syncthreads();
        if (tid < 256) s[tid] = 0.f;
        __syncthreads();
        for (int c = 0; c < 128; ++c) {
            const float* Pc = Pb + (size_t)(bh * 128 + c) * 4096; float* Uc = Ub + (size_t)(bh * 128 + c) * 4096;
            float pk[8];
#pragma unroll
            for (int x = 0; x < 8; ++x) pk[x] = Pc[(8 * kq + x) * 64 + j];
#pragma unroll
            for (int ri = 0; ri < 4; ++ri) { float a = 0.f;
#pragma unroll
                for (int x = 0; x < 8; ++x) a += s[ri * 64 + 8 * kq + x] * pk[x];
                red[(kq * 4 + ri) * 64 + j] = a; }
            __syncthreads();
            if (tid < 256) { const int ri = tid >> 6; float v = Uc[(4 * rg + ri) * 64 + j];
#pragma unroll
                for (int q = 0; q < 8; ++q) v += red[(q * 4 + ri) * 64 + j];
                s[tid] = v; Uc[(4 * rg + ri) * 64 + j] = v; }
            __syncthreads();
        }
    }
}

enum { PH_INIT = 0, PH_INPROJ, PH_RETKV, PH_RETSCAN, PH_RETOUT, PH_LORA, PH_SCAN1, PH_COMBINE, PH_SCAN3, PH_SWA, PH_FFN1, PH_OUTPROJ, PH_RMS };
template <int PH>
__device__ __forceinline__ void do_phase(const Params& p, int layer, int part, unsigned char* lds) {
    bf16* wb = (bf16*)p.ws;
    bf16* Z = (bf16*)(p.ws + WS_Z); bf16* XN = (bf16*)(p.ws + WS_XN); float* Pb = (float*)(p.ws + WS_P); float* Ub = (float*)(p.ws + WS_U);
    float* H = p.out;
    const int i = layer >> 1; const bool even = (layer & 1) == 0;
    if constexpr (PH == PH_INIT) { weights_phase(p, lds); rms_phase(p.x, H, p.norm1_g, XN, nullptr); }
    if constexpr (PH == PH_INPROJ) {
        const bf16* Bt = even ? wb + E_WIN + (size_t)i * 3840 * 1024 : wb + E_WQKV + (size_t)i * 1536 * 1024;
        const int N = even ? EVEN_IN : QKVW;
        EpiStore E{Z, N, even ? nullptr : p.swa_b_qkv + i * QKVW}; run_gemm(lds, XN, Bt, MTOK, N, DM, E);
    }
    if constexpr (PH == PH_RETKV) { ret_kv_phase(Z, Pb, lds); prepA_phase(Z, p.rwkv_mu + i * 1792, (bf16*)Ub); }
    if constexpr (PH == PH_RETSCAN) ret_scan_phase(Pb);
    if constexpr (PH == PH_RETOUT) ret_out_phase(Z, Pb, XN, lds);
    if constexpr (PH == PH_LORA) { EpiLora E{Z, p.rwkv_w0 + i * 512, p.rwkv_a0 + i * 512}; run_gemm(lds, (const bf16*)Ub, wb + E_WL + (size_t)i * 1536 * 256, MTOK, 1536, 256, E); }
    if constexpr (PH == PH_SCAN1 || PH == PH_SCAN3) {
        const RwkvW rw{p.rwkv_mu + i * 1792, p.rwkv_k_k + i * 512, p.rwkv_k_a + i * 512, p.rwkv_r_k + i * 512, p.rwkv_ln_g + i * 512, p.rwkv_ln_b + i * 512};
        rwkv_scan_phase<PH == PH_SCAN1 ? 1 : 3>(Z, rw, Pb, Ub, XN, lds);
    }
    if constexpr (PH == PH_COMBINE) rwkv_combine_phase(Pb, Ub, lds);
    if constexpr (PH == PH_SWA) swa_phase(Z, XN, p.swa_sinks + i * 16, lds);
    if constexpr (PH == PH_FFN1) { EpiSwiglu E{Z, FF}; run_gemm(lds, XN, wb + E_WGU + (size_t)layer * 5632 * 1024, MTOK, 2 * FF, DM, E); }
    if constexpr (PH == PH_OUTPROJ) {
        const bf16* A = part == 0 ? XN : Z;
        const bf16* Bt = part == 0 ? (even ? wb + E_WOUT + (size_t)i * 1024 * 1024 : wb + E_WO + (size_t)i * 1024 * 1024) : wb + E_WD + (size_t)layer * 1024 * FF;
        const float* bias = (part == 0 && !even) ? p.swa_b_o + i * DM : nullptr;
        EpiRes E{H, DM, bias}; run_gemm(lds, A, Bt, MTOK, DM, part == 0 ? DM : FF, E);
    }
    if constexpr (PH == PH_RMS) {
        const bool fin = (part == 1 && layer == 3);
        const float* g = part == 0 ? p.norm2_g + layer * DM : (fin ? p.final_g : p.norm1_g + (layer + 1) * DM);
        rms_phase(H, nullptr, g, fin ? nullptr : XN, fin ? H : nullptr);
    }
}

#ifndef FUSED
#define FUSED 1
#endif
#if FUSED
__global__ void __launch_bounds__(NTHR, 2) trunk_fwd(Params p) {
    extern __shared__ __attribute__((aligned(16))) unsigned char lds[];
    cg::grid_group grid = cg::this_grid();
    do_phase<PH_INIT>(p, 0, 0, lds);
    grid.sync();
    for (int hl = 0; hl < 8; ++hl) {
        const int layer = hl >> 1, part = hl & 1;
        if (part == 0) {
            do_phase<PH_INPROJ>(p, layer, part, lds); grid.sync();
            if ((layer & 1) == 0) {
                do_phase<PH_RETKV>(p, layer, part, lds); grid.sync();
                do_phase<PH_RETSCAN>(p, layer, part, lds); grid.sync();
                do_phase<PH_RETOUT>(p, layer, part, lds); grid.sync();
                do_phase<PH_LORA>(p, layer, part, lds); grid.sync();
                do_phase<PH_SCAN1>(p, layer, part, lds); grid.sync();
                do_phase<PH_COMBINE>(p, layer, part, lds); grid.sync();
                do_phase<PH_SCAN3>(p, layer, part, lds); grid.sync();
            } else {
                do_phase<PH_SWA>(p, layer, part, lds); grid.sync();
            }
        } else {
            do_phase<PH_FFN1>(p, layer, part, lds); grid.sync();
        }
        do_phase<PH_OUTPROJ>(p, layer, part, lds); grid.sync();
        do_phase<PH_RMS>(p, layer, part, lds);
        if (hl < 7) grid.sync();
    }
}
#else
template <int PH>
__global__ void __launch_bounds__(NTHR, 2) phase_k(Params p, int layer, int part) {
    extern __shared__ __attribute__((aligned(16))) unsigned char lds[];
    do_phase<PH>(p, layer, part, lds);
}
#endif

extern "C" void kernel_launch(void* const* d_in, const int* in_sizes, int n_in, void* d_out, int out_size, void* d_ws, size_t ws_size, hipStream_t stream) {
    static int grid = 0;
    if (grid == 0) {
        if (n_in != 25 || out_size != MTOK * DM || ws_size < WS_END) { fprintf(stderr, "kernel_launch: unexpected shapes (n_in %d out %d ws %zu)\n", n_in, out_size, ws_size); grid = -1; return; }
        int dev = 0, cus = 0;
        (void)hipGetDevice(&dev); (void)hipDeviceGetAttribute(&cus, hipDeviceAttributeMultiprocessorCount, dev);
#if FUSED
        int per_cu = 0;
        (void)hipFuncSetAttribute((const void*)trunk_fwd, hipFuncAttributeMaxDynamicSharedMemorySize, LDS_BYTES);
        (void)hipOccupancyMaxActiveBlocksPerMultiprocessor(&per_cu, (const void*)trunk_fwd, NTHR, LDS_BYTES);
        if (per_cu < 1) per_cu = 1;
        grid = cus * per_cu;
#else
#define SETATTR(PH) (void)hipFuncSetAttribute((const void*)phase_k<PH>, hipFuncAttributeMaxDynamicSharedMemorySize, LDS_BYTES)
        SETATTR(PH_INIT); SETATTR(PH_INPROJ); SETATTR(PH_RETKV); SETATTR(PH_RETSCAN); SETATTR(PH_RETOUT); SETATTR(PH_LORA); SETATTR(PH_SCAN1); SETATTR(PH_COMBINE);
        SETATTR(PH_SCAN3); SETATTR(PH_SWA); SETATTR(PH_FFN1); SETATTR(PH_OUTPROJ); SETATTR(PH_RMS);
        grid = cus;
#endif
        (void)hipGetLastError();
    }
    if (grid < 0) return;
    Params p{};
    const float** pp = (const float**)&p;
    for (int i = 0; i < 25; ++i) pp[i] = (const float*)d_in[i];
    p.out = (float*)d_out; p.ws = (unsigned char*)d_ws;
#if FUSED
    void* args[] = {&p};
    hipError_t e = hipLaunchCooperativeKernel((const void*)trunk_fwd, dim3(grid), dim3(NTHR), args, LDS_BYTES, stream);
    if (e != hipSuccess) fprintf(stderr, "cooperative launch failed: %s (grid %d)\n", hipGetErrorString(e), grid);
#else
#define LAUNCH(PH, layer, part) hipLaunchKernelGGL(phase_k<PH>, dim3(grid), dim3(NTHR), LDS_BYTES, stream, p, layer, part)
    LAUNCH(PH_INIT, 0, 0);
    for (int hl = 0; hl < 8; ++hl) {
        const int layer = hl >> 1, part = hl & 1;
        if (part == 0) {
            LAUNCH(PH_INPROJ, layer, part);
            if ((layer & 1) == 0) { LAUNCH(PH_RETKV, layer, part); LAUNCH(PH_RETSCAN, layer, part); LAUNCH(PH_RETOUT, layer, part); LAUNCH(PH_LORA, layer, part);
                LAUNCH(PH_SCAN1, layer, part); LAUNCH(PH_COMBINE, layer, part); LAUNCH(PH_SCAN3, layer, part); }
            else LAUNCH(PH_SWA, layer, part);
        } else LAUNCH(PH_FFN1, layer, part);
        LAUNCH(PH_OUTPROJ, layer, part);
        LAUNCH(PH_RMS, layer, part);
    }
#endif
}
```

```cpp
#include <hip/hip_runtime.h>
#include <hip/hip_cooperative_groups.h>
#include <cstdio>
#include <cstdint>
#include <cmath>
namespace cg = cooperative_groups;
__device__ __forceinline__ int opaque_tid() { int t = threadIdx.x; asm volatile("" : "+v"(t)); return t; }
__device__ __forceinline__ int opaque_bid() { int b = blockIdx.x; asm volatile("" : "+s"(b)); return b; }
#define FUSED 1
#define SLOG 3
#define PG8_WGM 4
#ifndef PG8_WGM
#define PG8_WGM 8
#endif
namespace pg8 {
#define PG8_LAS __attribute__((address_space(3)))
typedef unsigned short bf16_t;
typedef short bf16x8 __attribute__((ext_vector_type(8)));
typedef float f32x4 __attribute__((ext_vector_type(4)));
typedef unsigned u32x4 __attribute__((ext_vector_type(4)));
constexpr int BM = 256, BK = 64, HALF = 128, HTB = HALF * BK * 2  , STAGE_BYTES = 8 * HTB, NXCD = 8, WGM = PG8_WGM;

__host__ __device__ __forceinline__ int lds_byte(int r, int c) { const int st = (r >> 4) * 2 + (c >> 5), rr = r & 15, cc = c & 31, ob = rr * 64 + cc * 2; return st * 1024 + (ob ^ (((ob >> 9) & 1) << 5)); }
__host__ __device__ __forceinline__ void stage_rc(int b, int& R, int& C) { const int st = b / 1024, sb = b % 1024, swz = sb ^ (((sb >> 9) & 1) << 5); R = (st >> 1) * 16 + swz / 64; C = (st & 1) * 32 + (swz % 64) / 2; }
__host__ __device__ __forceinline__ int perm32(int rho) { const int n = rho >> 4, i = rho & 15; return 8 * (i >> 2) + 4 * n + (i & 3); }

struct Unit { int pm, pn; };
struct Gemm { const bf16_t* A; const bf16_t* Bt; int M, N, K; };

struct StaticOrder {
    int nM, nN, nwg, G, c;
    __host__ __device__ void init(int M, int N, int G_, int c_) { nM = M / BM; nN = N / BM; nwg = nM * nN; G = G_; c = c_; }
    __host__ __device__ bool next(int i, Unit& u) const {
        const long L = (long)i * G + c; if (L >= nwg) return false;
        int wgid = (int)L; { const int q = nwg / NXCD, r = nwg % NXCD, xcd = wgid % NXCD, off = wgid / NXCD; wgid = (xcd < r ? xcd * (q + 1) : r * (q + 1) + (xcd - r) * q) + off; }
        const int nig = WGM * nN, gid = wgid / nig, fm = gid * WGM, gsz = (nM - fm) < WGM ? (nM - fm) : WGM;
        u.pm = fm + ((wgid % nig) % gsz); u.pn = (wgid % nig) / gsz; return true;
    }
    __device__ __forceinline__ void a_ready(const Unit&) const {}
    __device__ __forceinline__ void done(const Unit&) const {}
};

__device__ __forceinline__ unsigned cvt_pk_bf16(float lo, float hi) { unsigned r; asm volatile("v_cvt_pk_bf16_f32 %0, %1, %2" : "=v"(r) : "v"(lo), "v"(hi)); return r; }
typedef float f32x2 __attribute__((ext_vector_type(2)));
__device__ __forceinline__ f32x2 gelu_pk(f32x2 v) {
    const f32x2 av = __builtin_elementwise_abs(v), d = av * 0.2316418882f + 1.0f;
    f32x2 t; t.x = __builtin_amdgcn_rcpf(d.x); t.y = __builtin_amdgcn_rcpf(d.y);
    f32x2 q = t * 0.5307027145f + (-0.7265760135f); q = q * t + 0.7107068705f; q = q * t + (-0.142248368f); q = q * t + 0.127414796f; q = q * t;
    const f32x2 s = (v * v) * (-0.72134752044f);
    f32x2 e; e.x = __builtin_amdgcn_exp2f(s.x); e.y = __builtin_amdgcn_exp2f(s.y);
    const f32x2 m = v * (q * e), r = v - m;
    f32x2 o; o.x = v.x < 0.f ? m.x : r.x; o.y = v.y < 0.f ? m.y : r.y; return o;
}

template <int ACT  > struct EpiBf16 {
    static constexpr bool PERM = true, AFTER_DRAIN = false; static_assert(ACT == 0 || ACT == 1, "EpiBf16: ACT is 0 (none) or 1 (gelu_pk)");
    bf16_t* O; int ldc; const float* bias; int split_cols; size_t split_stride; float scale0;
    __device__ __forceinline__ void operator()(const f32x4 (&acc)[2][2][4][2], const Unit& u, int wr, int wc, int fr, int fq) const {
        const int row0 = u.pm * BM + wr * 64 + fr; int colt = u.pn * BM; bf16_t* base = O;
        float sc = 1.f; if (split_cols) { const int t = colt / split_cols; base += (size_t)t * split_stride; colt -= t * split_cols; if (t == 0) sc = scale0; }
        const int col0 = colt + wc * 32 + 8 * fq, bcol0 = u.pn * BM + wc * 32 + 8 * fq;
        f32x4 bv[2][2];
#pragma unroll
        for (int bj = 0; bj < 2; ++bj)
#pragma unroll
            for (int n = 0; n < 2; ++n) bv[bj][n] = bias ? *(const f32x4*)(bias + bcol0 + bj * HALF + 4 * n) : (f32x4){0.f, 0.f, 0.f, 0.f};
#pragma unroll
        for (int ai = 0; ai < 2; ++ai)
#pragma unroll
            for (int m = 0; m < 4; ++m) { bf16_t* rowp = base + (size_t)(row0 + ai * HALF + m * 16) * ldc + col0;
#pragma unroll
                for (int bj = 0; bj < 2; ++bj) { f32x4 v0 = acc[ai][bj][m][0] + bv[bj][0], v1 = acc[ai][bj][m][1] + bv[bj][1];
                    if (ACT == 1) { f32x2 a = gelu_pk((f32x2){v0[0], v0[1]}), b = gelu_pk((f32x2){v0[2], v0[3]}), c = gelu_pk((f32x2){v1[0], v1[1]}), d = gelu_pk((f32x2){v1[2], v1[3]});
                        v0 = (f32x4){a.x, a.y, b.x, b.y}; v1 = (f32x4){c.x, c.y, d.x, d.y}; }
                    v0 = v0 * sc; v1 = v1 * sc; u32x4 w; w.x = cvt_pk_bf16(v0[0], v0[1]); w.y = cvt_pk_bf16(v0[2], v0[3]); w.z = cvt_pk_bf16(v1[0], v1[1]); w.w = cvt_pk_bf16(v1[2], v1[3]);
                    *(u32x4*)(rowp + bj * HALF) = w; } }
    }
};

template <class Epi, class Sched, bool ALIGN_EPI = false, bool SP2 = false>
__device__ __forceinline__ void gemm_phase(PG8_LAS unsigned char* lds, const Gemm g, const Sched& S, const Epi& E) {
    const int tid = opaque_tid(), wid = __builtin_amdgcn_readfirstlane(tid >> 6), lane = tid & 63, wr = wid >> 2, wc = wid & 3, fr = lane & 15, fq = lane >> 4;
    const int K = g.K, nt = K / BK;
    unsigned voffA[2], voffB[2];
#pragma unroll
    for (int i = 0; i < 2; ++i) { int R, C; stage_rc(tid * 16 + i * 8192, R, C); const int Rb = Epi::PERM ? ((R & ~31) + perm32(R & 31)) : R;
        voffA[i] = (unsigned)(R * K + C) * 2u; voffB[i] = (unsigned)(Rb * K + C) * 2u; }
    const size_t kstep = (size_t)(BK * 2);
    const size_t hstep = (size_t)HALF * K * 2;
    const size_t tstep = 2 * hstep;
    const unsigned ldsw = (unsigned)wid * 1024u;
    const int aoff = lds_byte(wr * 64 + fr, fq * 8), boff = lds_byte(wc * 32 + fr, fq * 8);
#define PG8_SA(b, h) (((b) * 2 + (h)) * HTB)
#define PG8_SB(b, h) ((4 + (b) * 2 + (h)) * HTB)
#define PG8_STAGE(bufoff, gbase, voff) do { _Pragma("unroll") for (int _i = 0; _i < 2; ++_i) \
        __builtin_amdgcn_global_load_lds((const unsigned*)((const char*)(gbase) + (voff)[_i]), (PG8_LAS unsigned*)(lds + (bufoff) + ldsw + _i * 8192), 16, 0, 0); } while (0)
#define PG8_LDA(dst, b, h) do { _Pragma("unroll") for (int m = 0; m < 4; ++m) _Pragma("unroll") for (int k = 0; k < 2; ++k) dst[m][k] = *(const PG8_LAS bf16x8*)(lds + PG8_SA(b, h) + aoff + m * 2048 + k * 1024); } while (0)
#define PG8_LDB(dst, b, h) do { _Pragma("unroll") for (int n = 0; n < 2; ++n) _Pragma("unroll") for (int k = 0; k < 2; ++k) dst[n][k] = *(const PG8_LAS bf16x8*)(lds + PG8_SB(b, h) + boff + n * 2048 + k * 1024); } while (0)
#define PG8_MMA(ai, bj, At, Bt) do { __builtin_amdgcn_s_setprio(1); _Pragma("unroll") for (int m = 0; m < 4; ++m) _Pragma("unroll") for (int n = 0; n < 2; ++n) _Pragma("unroll") for (int k = 0; k < 2; ++k) \
        acc[ai][bj][m][n] = __builtin_amdgcn_mfma_f32_16x16x32_bf16(Bt[n][k], At[m][k], acc[ai][bj][m][n], 0, 0, 0); __builtin_amdgcn_s_setprio(0); } while (0)
#define PG8_WAIT_V(n) asm volatile("s_waitcnt vmcnt(" #n ")" ::: "memory")
#define PG8_WAIT_L(n) asm volatile("s_waitcnt lgkmcnt(" #n ")" ::: "memory")
#define PG8_BAR __builtin_amdgcn_s_barrier()
#define PG8_SCHED __builtin_amdgcn_sched_barrier(0)
    Unit cur, nxt; int ui = 0;
    if (!S.next(0, cur)) return;
    f32x4 acc[2][2][4][2];
#pragma unroll
    for (int a = 0; a < 2; ++a)
#pragma unroll
        for (int b = 0; b < 2; ++b)
#pragma unroll
            for (int m = 0; m < 4; ++m)
#pragma unroll
                for (int n = 0; n < 2; ++n) acc[a][b][m][n] = (f32x4){0.f, 0.f, 0.f, 0.f};
    bf16x8 At[4][2], B0[2][2], B1[2][2];
    const char* cA = (const char*)g.A + (size_t)cur.pm * tstep; const char* cB = (const char*)g.Bt + (size_t)cur.pn * tstep;
    S.a_ready(cur);
    if constexpr (SP2) {
        PG8_STAGE(PG8_SB(0, 0), cB, voffB); PG8_STAGE(PG8_SB(0, 1), cB + hstep, voffB); PG8_STAGE(PG8_SA(0, 0), cA, voffA); PG8_STAGE(PG8_SA(0, 1), cA + hstep, voffA);
        if (wr == 1) PG8_BAR;
        PG8_WAIT_V(2); PG8_BAR;
        PG8_STAGE(PG8_SB(1, 0), cB + kstep, voffB); PG8_STAGE(PG8_SA(1, 0), cA + kstep, voffA); PG8_STAGE(PG8_SB(1, 1), cB + hstep + kstep, voffB);
        PG8_WAIT_V(6); PG8_BAR;
    } else {
        PG8_STAGE(PG8_SB(0, 0), cB, voffB); PG8_STAGE(PG8_SA(0, 0), cA, voffA); PG8_STAGE(PG8_SB(0, 1), cB + hstep, voffB); PG8_STAGE(PG8_SA(0, 1), cA + hstep, voffA);
        if (wr == 1) PG8_BAR;
        PG8_WAIT_V(4); PG8_BAR;
        PG8_STAGE(PG8_SB(1, 0), cB + kstep, voffB); PG8_STAGE(PG8_SA(1, 0), cA + kstep, voffA); PG8_STAGE(PG8_SB(1, 1), cB + hstep + kstep, voffB);
        PG8_WAIT_V(6); PG8_BAR;
    }
    for (;;) {
        const bool has_next = S.next(ui + 1, nxt);
        const char* nA = has_next ? (const char*)g.A + (size_t)nxt.pm * tstep : cA; const char* nB = has_next ? (const char*)g.Bt + (size_t)nxt.pn * tstep : cB;
        for (int t = 0; t < nt; t += 2) {
            const bool last = (t == nt - 2);
            const char* a1 = cA + (size_t)(t + 1) * kstep;
            const char* a2 = last ? nA : cA + (size_t)(t + 2) * kstep; const char* b2 = last ? nB : cB + (size_t)(t + 2) * kstep;
            const char* a3 = a2 + kstep; const char* b3 = b2 + kstep;
            if (last && has_next) S.a_ready(nxt);
            if constexpr (SP2) {
            PG8_LDB(B0, 0, 0); PG8_LDB(B1, 0, 1); PG8_SCHED; PG8_LDA(At, 0, 0); PG8_STAGE(PG8_SA(1, 1), a1 + hstep, voffA);
            PG8_WAIT_V(8); PG8_WAIT_L(0); PG8_BAR; PG8_MMA(0, 0, At, B0); PG8_MMA(0, 1, At, B1); PG8_BAR; PG8_SCHED;
            PG8_LDA(At, 0, 1); PG8_STAGE(PG8_SB(0, 0), b2, voffB); PG8_STAGE(PG8_SB(0, 1), b2 + hstep, voffB); PG8_STAGE(PG8_SA(0, 0), a2, voffA);
            PG8_WAIT_V(8); PG8_WAIT_L(0); PG8_BAR; PG8_MMA(1, 0, At, B0); PG8_MMA(1, 1, At, B1); PG8_BAR; PG8_SCHED;
            PG8_LDB(B0, 1, 0); PG8_LDB(B1, 1, 1); PG8_SCHED; PG8_LDA(At, 1, 0); PG8_STAGE(PG8_SA(0, 1), a2 + hstep, voffA);
            PG8_WAIT_V(8); PG8_WAIT_L(0); PG8_BAR; PG8_MMA(0, 0, At, B0); PG8_MMA(0, 1, At, B1); PG8_BAR; PG8_SCHED;
            PG8_LDA(At, 1, 1); PG8_STAGE(PG8_SB(1, 0), b3, voffB); PG8_STAGE(PG8_SB(1, 1), b3 + hstep, voffB); PG8_STAGE(PG8_SA(1, 0), a3, voffA);
            PG8_WAIT_V(8); PG8_WAIT_L(0); PG8_BAR; PG8_MMA(1, 0, At, B0); PG8_MMA(1, 1, At, B1); PG8_BAR; PG8_SCHED;
            } else {
            PG8_LDB(B0, 0, 0); PG8_SCHED; PG8_LDA(At, 0, 0); PG8_STAGE(PG8_SA(1, 1), a1 + hstep, voffA);
            PG8_WAIT_L(8); PG8_BAR; PG8_WAIT_L(0); PG8_MMA(0, 0, At, B0); PG8_BAR; PG8_SCHED;
            PG8_LDB(B1, 0, 1); PG8_STAGE(PG8_SB(0, 0), b2, voffB);
            PG8_BAR; PG8_WAIT_L(0); PG8_MMA(0, 1, At, B1); PG8_BAR;
            PG8_LDA(At, 0, 1); PG8_STAGE(PG8_SA(0, 0), a2, voffA);
            PG8_BAR; PG8_WAIT_L(0); PG8_MMA(1, 0, At, B0); PG8_BAR; PG8_SCHED;
            PG8_STAGE(PG8_SB(0, 1), b2 + hstep, voffB);
            PG8_WAIT_V(6); PG8_BAR; PG8_MMA(1, 1, At, B1); PG8_BAR;
            PG8_LDB(B0, 1, 0); PG8_SCHED; PG8_LDA(At, 1, 0); PG8_STAGE(PG8_SA(0, 1), a2 + hstep, voffA);
            PG8_WAIT_L(8); PG8_BAR; PG8_WAIT_L(0); PG8_MMA(0, 0, At, B0); PG8_BAR; PG8_SCHED;
            PG8_LDB(B1, 1, 1); PG8_STAGE(PG8_SB(1, 0), b3, voffB);
            PG8_BAR; PG8_WAIT_L(0); PG8_MMA(0, 1, At, B1); PG8_BAR;
            PG8_LDA(At, 1, 1); PG8_STAGE(PG8_SA(1, 0), a3, voffA);
            PG8_BAR; PG8_WAIT_L(0); PG8_MMA(1, 0, At, B0); PG8_BAR; PG8_SCHED;
            PG8_STAGE(PG8_SB(1, 1), b3 + hstep, voffB);
            PG8_WAIT_V(6); PG8_BAR; PG8_MMA(1, 1, At, B1); PG8_BAR;
            }
        }
        if constexpr (ALIGN_EPI) { if (wr == 0) PG8_BAR; }
        if constexpr (!Epi::AFTER_DRAIN) { E(acc, cur, wr, wc, fr, fq); S.done(cur); }
        if (!has_next) break;
#pragma unroll
        for (int a = 0; a < 2; ++a)
#pragma unroll
            for (int b = 0; b < 2; ++b)
#pragma unroll
                for (int m = 0; m < 4; ++m)
#pragma unroll
                    for (int n = 0; n < 2; ++n) acc[a][b][m][n] = (f32x4){0.f, 0.f, 0.f, 0.f};
        cur = nxt; cA = nA; cB = nB; ++ui;
        if constexpr (ALIGN_EPI) { if (wr == 1) PG8_BAR; }
    }
    PG8_WAIT_V(0);
    if constexpr (!ALIGN_EPI) { if (wr == 0) PG8_BAR; }
    PG8_BAR;
    if constexpr (Epi::AFTER_DRAIN) { E.fused(acc, cur, wr, wc, fr, fq, lds, wid, lane); S.done(cur); }
#undef PG8_SA
#undef PG8_SB
#undef PG8_STAGE
#undef PG8_LDA
#undef PG8_LDB
#undef PG8_MMA
#undef PG8_WAIT_V
#undef PG8_WAIT_L
#undef PG8_BAR
#undef PG8_SCHED
}
}

typedef unsigned short bf16;
typedef short bf16x8 __attribute__((ext_vector_type(8)));
typedef float f32x4 __attribute__((ext_vector_type(4)));
typedef unsigned u32x4 __attribute__((ext_vector_type(4)));
typedef unsigned u32x2 __attribute__((ext_vector_type(2)));

constexpr int SEQ = 16384, MTOK = 32768, DM = 1024, EVEN_IN = 3840, FF = 2816, QKVW = 1536;
constexpr int NTHR = 512;
constexpr size_t MiB = 1u << 20;
constexpr size_t E_WIN = 0, E_WOUT = E_WIN + 2ull * 3840 * 1024, E_WQKV = E_WOUT + 2ull * 1024 * 1024, E_WO = E_WQKV + 2ull * 1536 * 1024,
                 E_WGU = E_WO + 2ull * 1024 * 1024, E_WD = E_WGU + 4ull * 5632 * 1024, E_WL = E_WD + 4ull * 1024 * 2816, E_WEND = E_WL + 2ull * 1536 * 256;
static_assert(E_WEND * 2 <= 97 * MiB, "weights");
constexpr size_t WS_Z = 97 * MiB, WS_XN = 337 * MiB, WS_RB = 401 * MiB, WS_CTL = 465 * MiB, CTL_BYTES = 65536, WS_SSQ = 466 * MiB, WS_ROPE = 482 * MiB, WS_BON = 486 * MiB, WS_END = 487 * MiB;
constexpr int LDS_BYTES = 147456, MISC_OFF = 131072 + 64;
#define LAS __attribute__((address_space(3)))

__device__ __forceinline__ float bf2f(bf16 v) { return __uint_as_float(((unsigned)v) << 16); }
__device__ __forceinline__ unsigned pk2(float lo, float hi) { unsigned r; asm("v_cvt_pk_bf16_f32 %0, %1, %2" : "=v"(r) : "v"(lo), "v"(hi)); return r; }
__device__ __forceinline__ unsigned f2bf(float f) { return pk2(f, f) & 0xffffu; }
__device__ __forceinline__ float sigmoidf_(float x) { return __builtin_amdgcn_rcpf(1.f + __builtin_amdgcn_exp2f(x * -1.4426950408889634f)); }
__device__ __forceinline__ float wave_sum(float v) {
#pragma unroll
    for (int o = 1; o < 64; o <<= 1) v += __shfl_xor(v, o);
    return v;
}
template <int CTRL> __device__ __forceinline__ float dpp_mov(float v) { return __int_as_float(__builtin_amdgcn_update_dpp(0, __float_as_int(v), CTRL, 0xF, 0xF, true)); }
__device__ __forceinline__ float red8(float v) { v += dpp_mov<0xB1>(v); v += dpp_mov<0x4E>(v); v += dpp_mov<0x141>(v); return v; }
__device__ __forceinline__ float red16(float v) { v += dpp_mov<0xB1>(v); v += dpp_mov<0x4E>(v); v += dpp_mov<0x141>(v); v += dpp_mov<0x140>(v); return v; }
__device__ __forceinline__ float max16(float v) { v = fmaxf(v, dpp_mov<0xB1>(v)); v = fmaxf(v, dpp_mov<0x4E>(v)); v = fmaxf(v, dpp_mov<0x141>(v)); v = fmaxf(v, dpp_mov<0x140>(v)); return v; }

__device__ __forceinline__ f32x4 mma16(const bf16* A, int lda, int r0, const bf16* Bt, int ldb, int c0, int k0, f32x4 acc, int lane) {
    const int r = lane & 15, q = lane >> 4;
    const bf16x8 a = *(const bf16x8*)(A + (r0 + r) * lda + k0 + q * 8);
    const bf16x8 b = *(const bf16x8*)(Bt + (c0 + r) * ldb + k0 + q * 8);
    return __builtin_amdgcn_mfma_f32_16x16x32_bf16(a, b, acc, 0, 0, 0);
}

struct Params {
    const float *x, *norm1_g, *norm2_g, *final_g, *even_w_in, *even_w_out, *rwkv_mu, *rwkv_w0, *rwkv_w_up, *rwkv_a0, *rwkv_a_up, *rwkv_g_up,
                *rwkv_k_k, *rwkv_k_a, *rwkv_r_k, *rwkv_ln_g, *rwkv_ln_b, *swa_w_qkv, *swa_b_qkv, *swa_sinks, *swa_w_o, *swa_b_o, *ffn_w_gate, *ffn_w_up, *ffn_w_down;
    float* out; unsigned char* ws;
};

__device__ __forceinline__ float row_rstd(const float* ssq, int row) {
    const f32x4* q = (const f32x4*)(ssq + (size_t)row * 16); const f32x4 a = q[0], b = q[1], c = q[2], d = q[3];
    const float s = ((a[0] + a[1]) + (a[2] + a[3])) + ((b[0] + b[1]) + (b[2] + b[3])) + ((c[0] + c[1]) + (c[2] + c[3])) + ((d[0] + d[1]) + (d[2] + d[3]));
    return rsqrtf(s * (1.f / DM) + 1e-6f);
}
struct EpiStore {
    static constexpr bool PERM = true, AFTER_DRAIN = false;
    bf16* O; int ldc; const float* bias; const float* tab; mutable int k;
    __device__ __forceinline__ void operator()(const pg8::f32x4 (&acc)[2][2][4][2], const pg8::Unit& u, int wr, int wc, int fr, int fq) const {
        const int row0 = u.pm * 256 + wr * 64 + fr, col0 = u.pn * 256 + wc * 32 + 8 * fq;
        f32x4 bv[2][2];
#pragma unroll
        for (int bj = 0; bj < 2; ++bj)
#pragma unroll
            for (int n = 0; n < 2; ++n) bv[bj][n] = bias ? *(const f32x4*)(bias + col0 + bj * 128 + 4 * n) : (f32x4){0.f, 0.f, 0.f, 0.f};
#pragma unroll
        for (int ai = 0; ai < 2; ++ai)
#pragma unroll
            for (int m = 0; m < 4; ++m) { const int row = row0 + ai * 128 + m * 16; bf16* rowp = O + (size_t)row * ldc + col0;
                const float sc = tab[k * 256 + wr * 64 + fr + ai * 128 + m * 16];
#pragma unroll
                for (int bj = 0; bj < 2; ++bj) { const f32x4 v0 = acc[ai][bj][m][0] * sc + bv[bj][0], v1 = acc[ai][bj][m][1] * sc + bv[bj][1];
                    u32x4 w; w.x = pk2(v0[0], v0[1]); w.y = pk2(v0[2], v0[3]); w.z = pk2(v1[0], v1[1]); w.w = pk2(v1[2], v1[3]);
                    *(u32x4*)(rowp + bj * 128) = w; } }
        ++k;
    }
};
struct EpiRes {
    static constexpr bool PERM = true, AFTER_DRAIN = false;
    bf16* RB; int ldc; const float* bias; float* ssq;
    __device__ __forceinline__ void operator()(const pg8::f32x4 (&acc)[2][2][4][2], const pg8::Unit& u, int wr, int wc, int fr, int fq) const {
        const int col0 = u.pn * 256 + wc * 32 + 8 * fq;
        f32x4 bv[2][2];
#pragma unroll
        for (int bj = 0; bj < 2; ++bj)
#pragma unroll
            for (int n = 0; n < 2; ++n) bv[bj][n] = bias ? *(const f32x4*)(bias + col0 + bj * 128 + 4 * n) : (f32x4){0.f, 0.f, 0.f, 0.f};
#pragma unroll
        for (int ai = 0; ai < 2; ++ai)
#pragma unroll
            for (int m = 0; m < 4; ++m) { const int r = u.pm * 256 + ai * 128 + wr * 64 + m * 16 + fr; bf16* rowp = RB + (size_t)r * ldc + col0;
                float ss = 0.f;
#pragma unroll
                for (int bj = 0; bj < 2; ++bj) { const u32x4 old = *(const u32x4*)(rowp + bj * 128); u32x4 w;
#pragma unroll
                    for (int x = 0; x < 4; ++x) { const int n = x >> 1, e = (x & 1) * 2;
                        const float lo = __uint_as_float(old[x] << 16) + acc[ai][bj][m][n][e] + bv[bj][n][e], hi = __uint_as_float(old[x] & 0xffff0000u) + acc[ai][bj][m][n][e + 1] + bv[bj][n][e + 1];
                        const unsigned pw = pk2(lo, hi); w[x] = pw;
                        const float rl = __uint_as_float(pw << 16), rh = __uint_as_float(pw & 0xffff0000u); ss += rl * rl + rh * rh; }
                    *(u32x4*)(rowp + bj * 128) = w; }
                ss += __shfl_xor(ss, 16); ss += __shfl_xor(ss, 32);
                if (fq == 0) ssq[(size_t)r * 16 + u.pn * 4 + wc] = ss; }
    }
};
struct EpiSwiglu {
    static constexpr bool PERM = true, AFTER_DRAIN = false;
    bf16* O; int ldc; const float* tab; mutable int k;
    __device__ __forceinline__ void operator()(const pg8::f32x4 (&acc)[2][2][4][2], const pg8::Unit& u, int wr, int wc, int fr, int fq) const {
        const int row0 = u.pm * 256 + wr * 64 + fr, col0 = u.pn * 128 + wc * 32 + 8 * fq;
#pragma unroll
        for (int ai = 0; ai < 2; ++ai)
#pragma unroll
            for (int m = 0; m < 4; ++m) { const int row = row0 + ai * 128 + m * 16; bf16* rowp = O + (size_t)row * ldc + col0;
                const float sc = tab[k * 256 + wr * 64 + fr + ai * 128 + m * 16], sce = sc * -1.4426950408889634f, sc2 = sc * sc;
                float v[8];
#pragma unroll
                for (int n = 0; n < 2; ++n)
#pragma unroll
                    for (int x = 0; x < 4; ++x) { const float g = acc[ai][0][m][n][x], up = acc[ai][1][m][n][x];
                        v[4 * n + x] = (g * up) * (sc2 * __builtin_amdgcn_rcpf(1.f + __builtin_amdgcn_exp2f(g * sce))); }
                u32x4 w; w.x = pk2(v[0], v[1]); w.y = pk2(v[2], v[3]); w.z = pk2(v[4], v[5]); w.w = pk2(v[6], v[7]);
                *(u32x4*)rowp = w; }
        ++k;
    }
};
#ifndef GEMM_ALIGN
#define GEMM_ALIGN true
#endif
template <class Epi>
__device__ __forceinline__ void run_gemm(unsigned char* lds, const bf16* A, const bf16* Bt, int M, int N, int K, const Epi& E) {
    asm volatile("" : "+s"(N), "+s"(K));
    pg8::Gemm g{A, Bt, M, N, K}; pg8::StaticOrder S; S.init(M, N, (int)gridDim.x, (int)opaque_bid());
    pg8::gemm_phase<Epi, pg8::StaticOrder, GEMM_ALIGN, true>((PG8_LAS unsigned char*)lds, g, S, E);
}

constexpr int RSTD_OFF = 131072 + 256;
template <class Epi>
__device__ __forceinline__ void run_gemm_norm(unsigned char* lds, const bf16* A, const bf16* Bt, int M, int N, int K, const Epi& E, const float* ssq) {
    { asm volatile("" : "+s"(N));
      float* tab = (float*)(lds + RSTD_OFF); const int tid = opaque_tid();
      pg8::StaticOrder S; S.init(M, N, (int)gridDim.x, opaque_bid()); pg8::Unit u;
      for (int i = 0; i < 15 && S.next(i, u); ++i) if (tid < 256) tab[i * 256 + tid] = row_rstd(ssq, u.pm * 256 + tid);
      __syncthreads(); }
    run_gemm(lds, A, Bt, M, N, K, E);
}
__device__ __forceinline__ void tr_item(const float* W, int K, int N, bf16* WT, int mode, const float* gk, float* scr, int item, int lane) {
    const int nblk = N / 32, kb = item / nblk, nb = item % nblk, k0 = 64 * kb, n0 = 32 * nb;
    float wv[32];
#pragma unroll
    for (int i = 0; i < 32; ++i) wv[i] = W[(size_t)(k0 + 2 * i + (lane >> 5)) * N + n0 + (lane & 31)];
    const float g0 = gk ? gk[k0 + (lane >> 5) + 2 * (lane & 31)] : 1.f;
#pragma unroll
    for (int i = 0; i < 32; ++i) scr[(2 * i + (lane >> 5)) * 33 + (lane & 31)] = wv[i] * __shfl(g0, i + 32 * (lane >> 5));
    asm volatile("s_waitcnt lgkmcnt(0)" ::: "memory");
    const int c = lane & 7;
    const int d0 = mode == 0 ? n0 : ((n0 >> 7) * 256 + (n0 & 127) + (mode == 2 ? 128 : 0));
#pragma unroll
    for (int j = 0; j < 4; ++j) { const int n = (lane >> 3) + 8 * j; const float* s = scr + (8 * c) * 33 + n;
        u32x4 o; o.x = pk2(s[0 * 33], s[1 * 33]); o.y = pk2(s[2 * 33], s[3 * 33]); o.z = pk2(s[4 * 33], s[5 * 33]); o.w = pk2(s[6 * 33], s[7 * 33]);
        *(u32x4*)(WT + (size_t)(d0 + n) * K + k0 + 8 * c) = o; }
    asm volatile("s_waitcnt lgkmcnt(0)" ::: "memory");
}
__device__ __forceinline__ void tr_matrix(const float* W, int K, int N, bf16* WT, int mode, const float* gk, float* scr, int gw, int ngw, int lane) {
    const int nitems = (K / 64) * (N / 32);
    for (int it = gw; it < nitems; it += ngw) tr_item(W, K, N, WT, mode, gk, scr, it, lane);
}
typedef const Params __attribute__((address_space(4)))* ParamsPtr;
__device__ __forceinline__ void weights_phase(ParamsPtr pq, unsigned char* lds) {
#define p (*pq)
    const int tid = opaque_tid(), lane = tid & 63, wave = tid >> 6;
    float* scr = (float*)(lds + wave * 16384);
    const int gw = opaque_bid() * 8 + wave, ngw = gridDim.x * 8;
    bf16* wb = (bf16*)p.ws;
    for (int l = 0; l < 2; ++l) {
        tr_matrix(p.even_w_in + (size_t)l * 1024 * 3840, 1024, 3840, wb + E_WIN + (size_t)l * 3840 * 1024, 0, p.norm1_g + (2 * l) * DM, scr, gw, ngw, lane);
        tr_matrix(p.even_w_out + (size_t)l * 1024 * 1024, 1024, 1024, wb + E_WOUT + (size_t)l * 1024 * 1024, 0, nullptr, scr, gw, ngw, lane);
        tr_matrix(p.swa_w_qkv + (size_t)l * 1024 * 1536, 1024, 1536, wb + E_WQKV + (size_t)l * 1536 * 1024, 0, p.norm1_g + (2 * l + 1) * DM, scr, gw, ngw, lane);
        tr_matrix(p.swa_w_o + (size_t)l * 1024 * 1024, 1024, 1024, wb + E_WO + (size_t)l * 1024 * 1024, 0, nullptr, scr, gw, ngw, lane);
    }
    for (int l = 0; l < 4; ++l) {
        tr_matrix(p.ffn_w_gate + (size_t)l * 1024 * FF, 1024, FF, wb + E_WGU + (size_t)l * 5632 * 1024, 1, p.norm2_g + l * DM, scr, gw, ngw, lane);
        tr_matrix(p.ffn_w_up + (size_t)l * 1024 * FF, 1024, FF, wb + E_WGU + (size_t)l * 5632 * 1024, 2, p.norm2_g + l * DM, scr, gw, ngw, lane);
        tr_matrix(p.ffn_w_down + (size_t)l * FF * 1024, FF, 1024, wb + E_WD + (size_t)l * 1024 * FF, 0, nullptr, scr, gw, ngw, lane);
    }
    const int gt = opaque_bid() * NTHR + tid, ngt = gridDim.x * NTHR;
    for (int idx = gt; idx < 2 * 1536 * 256; idx += ngt) {
        const int l = idx / (1536 * 256), r = idx % (1536 * 256), n = r >> 8, k = r & 255; float v = 0.f;
        if (n < 512) { if (k < 64) v = p.rwkv_w_up[(size_t)l * 64 * 512 + k * 512 + n]; }
        else if (n < 1024) { if (k >= 64 && k < 128) v = p.rwkv_a_up[(size_t)l * 64 * 512 + (k - 64) * 512 + (n - 512)]; }
        else { if (k >= 128) v = p.rwkv_g_up[(size_t)l * 128 * 512 + (k - 128) * 512 + (n - 1024)]; }
        wb[E_WL + idx] = (bf16)f2bf(v);
    }
#undef p
}
__device__ __forceinline__ void init_rows_phase(const float* x, bf16* RB, float* ssq) {
    const int tid = opaque_tid(), lane = tid & 63, wave = tid >> 6;
    const int gw = opaque_bid() * 8 + wave, ngw = gridDim.x * 8;
    f32x4 nx[4];
    if (gw < MTOK) {
#pragma unroll
        for (int j = 0; j < 4; ++j) nx[j] = ((const f32x4*)(x + (size_t)gw * DM))[lane + 64 * j];
    }
    for (int m = gw; m < MTOK; m += ngw) {
        f32x4 cv[4];
#pragma unroll
        for (int j = 0; j < 4; ++j) cv[j] = nx[j];
        if (m + ngw < MTOK) {
#pragma unroll
            for (int j = 0; j < 4; ++j) nx[j] = ((const f32x4*)(x + (size_t)(m + ngw) * DM))[lane + 64 * j];
        }
        float s = 0.f;
#pragma unroll
        for (int j = 0; j < 4; ++j) { const f32x4 v = cv[j]; u32x2 w; w.x = pk2(v[0], v[1]); w.y = pk2(v[2], v[3]); ((u32x2*)(RB + (size_t)m * DM))[lane + 64 * j] = w;
            const float a0 = __uint_as_float(w.x << 16), a1 = __uint_as_float(w.x & 0xffff0000u), a2 = __uint_as_float(w.y << 16), a3 = __uint_as_float(w.y & 0xffff0000u);
            s += (a0 * a0 + a1 * a1) + (a2 * a2 + a3 * a3); }
        s = wave_sum(s);
        if (lane < 16) ssq[(size_t)m * 16 + lane] = lane == 0 ? s : 0.f;
    }
}
__device__ __forceinline__ void final_rms_phase(const bf16* RB, const float* g, float* outf) {
    const int tid = opaque_tid(), lane = tid & 63, wave = tid >> 6;
    const int gw = opaque_bid() * 8 + wave, ngw = gridDim.x * 8;
    f32x4 gv[4];
#pragma unroll
    for (int j = 0; j < 4; ++j) gv[j] = ((const f32x4*)g)[lane + 64 * j];
    u32x2 nw[4];
    if (gw < MTOK) {
#pragma unroll
        for (int j = 0; j < 4; ++j) nw[j] = ((const u32x2*)(RB + (size_t)gw * DM))[lane + 64 * j];
    }
    for (int m = gw; m < MTOK; m += ngw) {
        u32x2 cw[4];
#pragma unroll
        for (int j = 0; j < 4; ++j) cw[j] = nw[j];
        if (m + ngw < MTOK) {
#pragma unroll
            for (int j = 0; j < 4; ++j) nw[j] = ((const u32x2*)(RB + (size_t)(m + ngw) * DM))[lane + 64 * j];
        }
        f32x4 v[4]; float s = 0.f;
#pragma unroll
        for (int j = 0; j < 4; ++j) { const u32x2 w = cw[j];
            v[j] = (f32x4){__uint_as_float(w.x << 16), __uint_as_float(w.x & 0xffff0000u), __uint_as_float(w.y << 16), __uint_as_float(w.y & 0xffff0000u)};
            s += (v[j][0] * v[j][0] + v[j][1] * v[j][1]) + (v[j][2] * v[j][2] + v[j][3] * v[j][3]); }
        const float rstd = rsqrtf(wave_sum(s) * (1.f / DM) + 1e-6f);
#pragma unroll
        for (int j = 0; j < 4; ++j) ((f32x4*)(outf + (size_t)m * DM))[lane + 64 * j] = v[j] * rstd * gv[j];
    }
}
__device__ __forceinline__ float rope_inv_freq(int p) { return exp2f(-(float)p * (13.287712379549449f / 31.0f)); }
typedef short s16x4 __attribute__((ext_vector_type(4)));
typedef float f32x2v __attribute__((ext_vector_type(2)));
__device__ __forceinline__ bf16x8 tr_frag(const bf16* X, int ld, int k0, int c0, int lane) {
    const int g = lane >> 4, i = lane & 15, q = i >> 2, pp = i & 3;
    const bf16* a0 = X + (k0 + g * 8 + q) * ld + c0 + 4 * pp;
    const s16x4 lo = __builtin_amdgcn_ds_read_tr16_b64_v4i16((LAS s16x4*)a0);
    const s16x4 hi = __builtin_amdgcn_ds_read_tr16_b64_v4i16((LAS s16x4*)(a0 + 4 * ld));
    return (bf16x8){lo[0], lo[1], lo[2], lo[3], hi[0], hi[1], hi[2], hi[3]};
}
__device__ __forceinline__ f32x4 mma16_tb(const bf16* A, int lda, int r0, const bf16* B, int ldb, int c0, int k0, f32x4 acc, int lane) {
    const bf16x8 a = *(const bf16x8*)(A + (r0 + (lane & 15)) * lda + k0 + (lane >> 4) * 8);
    return __builtin_amdgcn_mfma_f32_16x16x32_bf16(a, tr_frag(B, ldb, k0, c0, lane), acc, 0, 0, 0);
}
__device__ __forceinline__ void rope_table_phase(f32x2v* tab) {
    const int gt = opaque_bid() * NTHR + opaque_tid(), ngt = gridDim.x * NTHR;
    for (int idx = gt; idx < SEQ * 32; idx += ngt) { const float ang = (float)(idx >> 5) * rope_inv_freq(idx & 31); tab[idx] = (f32x2v){cosf(ang), sinf(ang)}; }
}
__device__ __forceinline__ void ret_kv_phase(bf16* Z, float* KV, const f32x2v* rope, unsigned char* lds) {
    bf16* Ks = (bf16*)lds; bf16* Vs = (bf16*)(lds + 18432);
    const int tid = opaque_tid(), lane = tid & 63, wave = tid >> 6, r16 = lane & 15, q4 = lane >> 4;
    u32x2 fql_[2], fqh_[2], fkl_[2], fkh_[2]; f32x4 fc0_[2], fc1_[2]; u32x4 fv_[2];
#define RK_FETCH(u_) do { const int b_ = (u_) >> 10, h_ = ((u_) >> 7) & 7, n_ = (u_) & 127; const size_t rb_ = (size_t)b_ * SEQ + n_ * 128; \
        _Pragma("unroll") for (int it = 0; it < 2; ++it) { const int idx = tid + it * NTHR, p4 = (idx & 7) * 4, i = idx >> 3; \
            const bf16* zq = Z + (rb_ + i) * EVEN_IN + h_ * 64 + p4; const f32x4* rp_ = (const f32x4*)(rope + (n_ * 128 + i) * 32 + p4); \
            fql_[it] = *(const u32x2*)zq; fqh_[it] = *(const u32x2*)(zq + 32); fkl_[it] = *(const u32x2*)(zq + 512); fkh_[it] = *(const u32x2*)(zq + 544); fc0_[it] = rp_[0]; fc1_[it] = rp_[1]; \
            fv_[it] = *(const u32x4*)(Z + (rb_ + (idx >> 3)) * EVEN_IN + 1024 + h_ * 64 + (idx & 7) * 8); } } while (0)
    { const int u0 = opaque_bid(); if (u0 < 2048) RK_FETCH(u0); }
    for (int u = opaque_bid(); u < 2048; u += gridDim.x) {
        const int b = u >> 10, h = (u >> 7) & 7, n = u & 127; const size_t rowbase = (size_t)b * SEQ + n * 128;
        const float lg = log1pf(-exp2f(-5.f - (float)h));
        __syncthreads();
#pragma unroll
        for (int it = 0; it < 2; ++it) { const int idx = tid + it * NTHR, p4 = (idx & 7) * 4, i = idx >> 3;
            bf16* zq = Z + (rowbase + i) * EVEN_IN + h * 64 + p4; bf16* zk = zq + 512;
            const f32x4 c01 = fc0_[it], c23 = fc1_[it];
            const float cs_[4] = {c01[0], c01[2], c23[0], c23[2]}, sn_[4] = {c01[1], c01[3], c23[1], c23[3]};
            const u32x2 ql = fql_[it], qh = fqh_[it], kl = fkl_[it], kh = fkh_[it];
            const float kd = __expf((float)(127 - i) * lg);
            float q1[4], q2[4], k1[4], k2[4];
#pragma unroll
            for (int x = 0; x < 4; ++x) { const int sh = 16 * (x & 1), wi = x >> 1;
                const float a1 = bf2f((bf16)(ql[wi] >> sh)), a2 = bf2f((bf16)(qh[wi] >> sh)), b1 = bf2f((bf16)(kl[wi] >> sh)), b2 = bf2f((bf16)(kh[wi] >> sh));
                q1[x] = a1 * cs_[x] - a2 * sn_[x]; q2[x] = a1 * sn_[x] + a2 * cs_[x];
                k1[x] = (b1 * cs_[x] - b2 * sn_[x]) * 0.125f; k2[x] = (b1 * sn_[x] + b2 * cs_[x]) * 0.125f; }
            *(u32x2*)zq = (u32x2){pk2(q1[0], q1[1]), pk2(q1[2], q1[3])}; *(u32x2*)(zq + 32) = (u32x2){pk2(q2[0], q2[1]), pk2(q2[2], q2[3])};
            *(u32x2*)zk = (u32x2){pk2(k1[0], k1[1]), pk2(k1[2], k1[3])}; *(u32x2*)(zk + 32) = (u32x2){pk2(k2[0], k2[1]), pk2(k2[2], k2[3])};
            *(u32x2*)(Ks + i * 72 + p4) = (u32x2){pk2(k1[0] * kd, k1[1] * kd), pk2(k1[2] * kd, k1[3] * kd)};
            *(u32x2*)(Ks + i * 72 + 32 + p4) = (u32x2){pk2(k2[0] * kd, k2[1] * kd), pk2(k2[2] * kd, k2[3] * kd)};
            *(u32x4*)(Vs + (idx >> 3) * 72 + (idx & 7) * 8) = fv_[it]; }
        __syncthreads();
        { const int un = u + (int)gridDim.x; if (un < 2048) RK_FETCH(un); }
        const int dtile = wave >> 1;
#pragma unroll
        for (int e2 = 0; e2 < 2; ++e2) { const int etile = (wave & 1) * 2 + e2; f32x4 acc = {0.f, 0.f, 0.f, 0.f};
#pragma unroll
            for (int k0 = 0; k0 < 128; k0 += 32) acc = __builtin_amdgcn_mfma_f32_16x16x32_bf16(tr_frag(Ks, 72, k0, 16 * dtile, lane), tr_frag(Vs, 72, k0, 16 * etile, lane), acc, 0, 0, 0);
#pragma unroll
            for (int jj = 0; jj < 4; ++jj) KV[((size_t)u * 64 + 16 * dtile + q4 * 4 + jj) * 64 + 16 * etile + r16] = acc[jj]; }
    }
}
template <bool STORE>
__device__ __forceinline__ void ret_scan_phase(float* KV) {
    const int gt = opaque_bid() * NTHR + opaque_tid(), ngt = gridDim.x * NTHR;
    for (int e = gt; e < 65536; e += ngt) {
        const int bh = e >> 12, de = e & 4095, h = bh & 7;
        const float cd = expf(128.f * log1pf(-exp2f(-5.f - (float)h)));
        float st = 0.f; float* ptr = KV + (size_t)bh * 128 * 4096 + de;
        float nk[16];
#pragma unroll
        for (int x = 0; x < 16; ++x) nk[x] = ptr[(size_t)x * 4096];
        for (int n0 = 0; n0 < 128; n0 += 16) { float kv[16];
#pragma unroll
            for (int x = 0; x < 16; ++x) kv[x] = nk[x];
            if (n0 + 16 < 128) {
#pragma unroll
                for (int x = 0; x < 16; ++x) nk[x] = ptr[(size_t)(n0 + 16 + x) * 4096];
            }
#pragma unroll
            for (int x = 0; x < 16; ++x) { if (STORE) ptr[(size_t)(n0 + x) * 4096] = st; st = cd * st + kv[x]; } }
        if (!STORE && st == 1.2345e-30f) ptr[0] = st;
    }
}
__device__ __forceinline__ void ret_out_phase(const bf16* Z, const float* KV, bf16* MIX, unsigned char* lds) {
    bf16* Qs = (bf16*)lds; bf16* Ks = (bf16*)(lds + 18432); bf16* Vs = (bf16*)(lds + 36864); bf16* Ss = (bf16*)(lds + 55296); bf16* Ps = (bf16*)(lds + 64512);
    const int tid = opaque_tid(), lane = tid & 63, wave = tid >> 6, r16 = lane & 15, q4 = lane >> 4;
    u32x4 fk_[2], fv_[2]; f32x4 fs_[2];
#define RO_FETCH(u_) do { const int b_ = (u_) >> 10, h_ = ((u_) >> 7) & 7, n_ = (u_) & 127; const size_t rb_ = (size_t)b_ * SEQ + n_ * 128; \
        _Pragma("unroll") for (int it = 0; it < 2; ++it) { const int ci = tid + it * NTHR, j = ci >> 3, c8 = (ci & 7) * 8; const bf16* src = Z + (rb_ + j) * EVEN_IN + h_ * 64 + c8; \
            fk_[it] = *(const u32x4*)(src + 512); fv_[it] = *(const u32x4*)(src + 1024); \
            fs_[it] = *(const f32x4*)(KV + (size_t)(u_) * 4096 + (ci >> 4) * 64 + (ci & 15) * 4); } } while (0)
    { const int u0 = opaque_bid(); if (u0 < 2048) RO_FETCH(u0); }
    for (int u = opaque_bid(); u < 2048; u += gridDim.x) {
        const int b = u >> 10, h = (u >> 7) & 7, n = u & 127; const size_t rowbase = (size_t)b * SEQ + n * 128;
        const float lg = log1pf(-exp2f(-5.f - (float)h));
        __syncthreads();
#pragma unroll
        for (int it = 0; it < 2; ++it) { const int ci = tid + it * NTHR, j = ci >> 3, c8 = (ci & 7) * 8;
            *(u32x4*)(Ks + j * 72 + c8) = fk_[it]; *(u32x4*)(Vs + j * 72 + c8) = fv_[it];
            u32x2 w; w.x = pk2(fs_[it][0], fs_[it][1]); w.y = pk2(fs_[it][2], fs_[it][3]); *(u32x2*)(Ss + (ci >> 4) * 72 + (ci & 15) * 4) = w; }
        bf16x8 qf[2];
#pragma unroll
        for (int ks = 0; ks < 2; ++ks) qf[ks] = *(const bf16x8*)(Z + (rowbase + 16 * wave + r16) * EVEN_IN + h * 64 + 32 * ks + q4 * 8);
        __syncthreads();
        { const int un = u + (int)gridDim.x; if (un < 2048) RO_FETCH(un); }
        f32x4 acc[8];
#pragma unroll
        for (int kt = 0; kt < 8; ++kt) { acc[kt] = (f32x4){0.f, 0.f, 0.f, 0.f};
            if (kt <= wave) {
#pragma unroll
                for (int ks = 0; ks < 2; ++ks) acc[kt] = __builtin_amdgcn_mfma_f32_16x16x32_bf16(qf[ks], *(const bf16x8*)(Ks + (16 * kt + r16) * 72 + 32 * ks + q4 * 8), acc[kt], 0, 0, 0); } }
#pragma unroll
        for (int kt = 0; kt < 8; ++kt)
#pragma unroll
            for (int jj = 0; jj < 4; ++jj) { const int i = 16 * wave + q4 * 4 + jj, j = 16 * kt + r16;
                const float val = (i >= j) ? acc[kt][jj] * __expf((float)(i - j) * lg) : 0.f;
                Ps[i * 136 + j] = (bf16)f2bf(val); }
        asm volatile("s_waitcnt lgkmcnt(0)" ::: "memory");
        f32x4 o[4], o2[4];
#pragma unroll
        for (int dt = 0; dt < 4; ++dt) { o[dt] = (f32x4){0.f, 0.f, 0.f, 0.f}; o2[dt] = (f32x4){0.f, 0.f, 0.f, 0.f};
#pragma unroll
            for (int k0 = 0; k0 < 128; k0 += 32) if (k0 <= 16 * wave) o[dt] = mma16_tb(Ps, 136, 16 * wave, Vs, 72, 16 * dt, k0, o[dt], lane);
#pragma unroll
            for (int ks = 0; ks < 2; ++ks) o2[dt] = __builtin_amdgcn_mfma_f32_16x16x32_bf16(qf[ks], tr_frag(Ss, 72, 32 * ks, 16 * dt, lane), o2[dt], 0, 0, 0); }
#pragma unroll
        for (int jj = 0; jj < 4; ++jj) { const int i = 16 * wave + q4 * 4 + jj; const float qd = __expf((float)(i + 1) * lg);
            float v[4]; float s = 0.f;
#pragma unroll
            for (int dt = 0; dt < 4; ++dt) { v[dt] = o[dt][jj] + qd * o2[dt][jj]; s += v[dt]; }
            const float mean = red16(s) * (1.f / 64.f); float q = 0.f;
#pragma unroll
            for (int dt = 0; dt < 4; ++dt) { v[dt] -= mean; q += v[dt] * v[dt]; }
            const float rstd = rsqrtf(red16(q) * (1.f / 64.f) + 1e-6f);
#pragma unroll
            for (int dt = 0; dt < 4; ++dt) Ps[i * 136 + 16 * dt + r16] = (bf16)f2bf(v[dt] * rstd); }
#pragma unroll
        for (int t2 = 0; t2 < 2; ++t2) { const int cidx = lane + 64 * t2, i = 16 * wave + (cidx >> 3), c8 = (cidx & 7) * 8;
            const u32x4 ov = *(const u32x4*)(Ps + i * 136 + c8), gv = *(const u32x4*)(Z + (rowbase + i) * EVEN_IN + 1536 + h * 64 + c8); u32x4 w;
#pragma unroll
            for (int x = 0; x < 4; ++x) { const float g0 = __uint_as_float(gv[x] << 16), g1 = __uint_as_float(gv[x] & 0xffff0000u);
                w[x] = pk2(__uint_as_float(ov[x] << 16) * g0 * sigmoidf_(g0), __uint_as_float(ov[x] & 0xffff0000u) * g1 * sigmoidf_(g1)); }
            *(u32x4*)(MIX + (rowbase + i) * DM + h * 64 + c8) = w; }
    }
}

__device__ __forceinline__ void swa_phase(const bf16* QKV, bf16* MIX, const float* sinks, unsigned char* lds) {
    bf16* Ks = (bf16*)lds; bf16* Vs = (bf16*)(lds + 36864); bf16* Qs = (bf16*)(lds + 73728); bf16* Ps = (bf16*)(lds + 92160);
    const int tid = opaque_tid(), lane = tid & 63, wave = tid >> 6, r16 = lane & 15, q4 = lane >> 4;
    u32x4 pk_[4], pv_[4];
#define SWA_FETCH(u_) do { const int b_ = (u_) >> 9, kvh_ = ((u_) >> 7) & 3, n_ = (u_) & 127; const size_t rb_ = (size_t)b_ * SEQ + n_ * 128; \
        _Pragma("unroll") for (int it = 0; it < 4; ++it) { const int ci = tid + it * NTHR, kj = ci >> 3, c8 = (ci & 7) * 8; pk_[it] = (u32x4){0u, 0u, 0u, 0u}; pv_[it] = (u32x4){0u, 0u, 0u, 0u}; \
            if (n_ > 0 || kj >= 128) { const bf16* src = QKV + (rb_ - 128 + kj) * QKVW + kvh_ * 64 + c8; pk_[it] = *(const u32x4*)(src + 1024); pv_[it] = *(const u32x4*)(src + 1280); } } } while (0)
    { const int u0 = opaque_bid(); if (u0 < 1024) SWA_FETCH(u0); }
    for (int u = opaque_bid(); u < 1024; u += gridDim.x) {
        const int b = u >> 9, kvh = (u >> 7) & 3, n = u & 127; const size_t rowbase = (size_t)b * SEQ + n * 128;
        __syncthreads();
#pragma unroll
        for (int it = 0; it < 4; ++it) { const int ci = tid + it * NTHR, kj = ci >> 3, c8 = (ci & 7) * 8; *(u32x4*)(Ks + kj * 72 + c8) = pk_[it]; *(u32x4*)(Vs + kj * 72 + c8) = pv_[it]; }
        __syncthreads();
        { const int un = u + (int)gridDim.x; if (un < 1024) SWA_FETCH(un); }
        for (int g = 0; g < 4; ++g) {
            const int hq = kvh * 4 + g;
            bf16x8 qf[2];
#pragma unroll
            for (int ks = 0; ks < 2; ++ks) qf[ks] = *(const bf16x8*)(QKV + (rowbase + 16 * wave + r16) * QKVW + hq * 64 + 32 * ks + q4 * 8);
            f32x4 acc[16];
            const float sink = sinks[hq];
            float mx[4] = {-INFINITY, -INFINITY, -INFINITY, -INFINITY};
#pragma unroll
            for (int kt = 0; kt < 16; ++kt) {
                if (kt >= wave && kt <= wave + 8) {
                    acc[kt] = (f32x4){0.f, 0.f, 0.f, 0.f};
#pragma unroll
                    for (int ks = 0; ks < 2; ++ks) acc[kt] = __builtin_amdgcn_mfma_f32_16x16x32_bf16(qf[ks], *(const bf16x8*)(Ks + (16 * kt + r16) * 72 + 32 * ks + q4 * 8), acc[kt], 0, 0, 0);
#pragma unroll
                    for (int jj = 0; jj < 4; ++jj) { const int qi = 16 * wave + q4 * 4 + jj, kj = 16 * kt + r16, rel = qi + 128 - kj;
                        const bool valid = (rel >= 0) && (rel < 128) && ((n > 0) || (kj >= 128));
                        const float sv = valid ? acc[kt][jj] * 0.125f : -INFINITY; acc[kt][jj] = sv; mx[jj] = fmaxf(mx[jj], sv); }
                } else acc[kt] = (f32x4){-INFINITY, -INFINITY, -INFINITY, -INFINITY};
            }
            float sum[4];
#pragma unroll
            for (int jj = 0; jj < 4; ++jj) { mx[jj] = fmaxf(max16(mx[jj]), sink); sum[jj] = 0.f; }
#pragma unroll
            for (int kt = 0; kt < 16; ++kt) {
                if (kt >= wave && kt <= wave + 8) {
#pragma unroll
                    for (int jj = 0; jj < 4; ++jj) { const float e = __expf(acc[kt][jj] - mx[jj]); acc[kt][jj] = e; sum[jj] += e; }
                } else acc[kt] = (f32x4){0.f, 0.f, 0.f, 0.f};
            }
#pragma unroll
            for (int jj = 0; jj < 4; ++jj) sum[jj] = red16(sum[jj]) + __expf(sink - mx[jj]);
            f32x4 o[4];
#pragma unroll
            for (int dt = 0; dt < 4; ++dt) o[dt] = (f32x4){0.f, 0.f, 0.f, 0.f};
#pragma unroll
            for (int half = 0; half < 2; ++half) {
#pragma unroll
                for (int k8 = 0; k8 < 8; ++k8)
#pragma unroll
                    for (int jj = 0; jj < 4; ++jj) Ps[(16 * wave + q4 * 4 + jj) * 136 + k8 * 16 + r16] = (bf16)f2bf(acc[half * 8 + k8][jj]);
                asm volatile("s_waitcnt lgkmcnt(0)" ::: "memory");
#pragma unroll
                for (int k0 = 0; k0 < 128; k0 += 32) { const int kt0 = half * 8 + (k0 >> 4);
                    if (kt0 + 1 >= wave && kt0 <= wave + 8) {
#pragma unroll
                        for (int dt = 0; dt < 4; ++dt) o[dt] = mma16_tb(Ps, 136, 16 * wave, Vs + half * 128 * 72, 72, 16 * dt, k0, o[dt], lane); } }
            }
#pragma unroll
            for (int jj = 0; jj < 4; ++jj) { const float inv = __builtin_amdgcn_rcpf(sum[jj]); const int i = 16 * wave + q4 * 4 + jj;
#pragma unroll
                for (int dt = 0; dt < 4; ++dt) Ps[i * 136 + 16 * dt + r16] = (bf16)f2bf(o[dt][jj] * inv); }
#pragma unroll
            for (int t2 = 0; t2 < 2; ++t2) { const int cidx = lane + 64 * t2, i = 16 * wave + (cidx >> 3), c8 = (cidx & 7) * 8;
                *(u32x4*)(MIX + (rowbase + i) * DM + hq * 64 + c8) = *(const u32x4*)(Ps + i * 136 + c8); }
        }
    }
}

struct RwkvW { const float *mu, *k_k, *k_a, *r_k, *ln_g, *ln_b, *w0, *a0; };
__device__ __forceinline__ float fma_s(float a, float b, float c) { float d; asm("v_fma_f32 %0, %1, %2, %3" : "=v"(d) : "v"(a), "v"(b), "v"(c)); return d; }
__device__ __forceinline__ float mul_s(float a, float b) { float d; asm("v_mul_f32 %0, %1, %2" : "=v"(d) : "v"(a), "v"(b)); return d; }
#ifndef SLOG
#define SLOG 3
#endif
constexpr int SCH = 128 << SLOG, NCHK = SEQ / SCH;
struct ScanRaw { u32x2 cr, ck, cv, pr, pk, pv, cwl, pwl, cal, pal; u32x4 cgl, pgl; };
typedef _Float16 h2 __attribute__((ext_vector_type(2)));
__device__ __forceinline__ h2 u2h(unsigned u) { return __builtin_bit_cast(h2, u); }
__device__ __forceinline__ unsigned pkh(float lo, float hi) { const h2 v = {(_Float16)lo, (_Float16)hi}; return __builtin_bit_cast(unsigned, v); }
__device__ __forceinline__ float hsum(h2 v) { return (float)v[0] + (float)v[1]; }
#define SCAN_STEPS(HASP)             { \
                const unsigned char* q = buf + j0 * 2; const unsigned char* qv = buf + O_V2 + rp * 4; \
                u32x4 na8 = *(const u32x4*)q, nb8 = *(const u32x4*)(q + O_B), nw8 = *(const u32x4*)(q + O_W), nk8 = *(const u32x4*)(q + O_K), nr8 = *(const u32x4*)(q + O_R); \
                unsigned nv = *(const unsigned*)qv; \
_Pragma("unroll 4") \
                for (int tt = 0; tt < 32; ++tt) { \
                    const u32x4 a8 = na8, b8 = nb8, w8 = nw8, k8 = nk8, r8 = nr8; const h2 vi2 = u2h(nv); \
                    { const int tn = (tt + 1) & 31;    \
                      na8 = *(const u32x4*)(q + tn * 128); nb8 = *(const u32x4*)(q + O_B + tn * 128); nw8 = *(const u32x4*)(q + O_W + tn * 128); nk8 = *(const u32x4*)(q + O_K + tn * 128); \
                      nr8 = *(const u32x4*)(q + O_R + tn * 128); \
                      nv = *(const unsigned*)(qv + tn * 256); } \
                    __builtin_amdgcn_sched_barrier(0); \
                    h2 du = SU[0] * u2h(a8[0]); \
_Pragma("unroll") \
                    for (int x = 1; x < 4; ++x) du = SU[x] * u2h(a8[x]) + du; \
                    const float sau = red8(hsum(du)); \
                    const h2 sau2 = {(_Float16)sau, (_Float16)sau}; \
                    if (PASS == 1 && HASP) { \
                        h2 dp = SP[0] * u2h(a8[0]); \
_Pragma("unroll") \
                        for (int x = 1; x < 4; ++x) dp = SP[x] * u2h(a8[x]) + dp; \
                        const float sap = red8(hsum(dp)); \
                        const h2 sap2 = {(_Float16)sap, (_Float16)sap}; \
_Pragma("unroll") \
                        for (int x = 0; x < 4; ++x) SP[x] = SP[x] * u2h(w8[x]) + sap2 * u2h(b8[x]); \
                    } \
_Pragma("unroll") \
                    for (int x = 0; x < 4; ++x) SU[x] = SU[x] * u2h(w8[x]) + (sau2 * u2h(b8[x]) + vi2 * u2h(k8[x])); \
                    if (PASS == 1) {    \
                        h2 dy = SU[0] * u2h(r8[0]), dq = SP[0] * u2h(r8[0]); \
_Pragma("unroll") \
                        for (int x = 1; x < 4; ++x) { dy = SU[x] * u2h(r8[x]) + dy; if (HASP) dq = SP[x] * u2h(r8[x]) + dq; } \
                        const float y = red8(hsum(dy)), rho = HASP ? red8(hsum(dq)) : 0.f; \
                        if (sl == 0) { *(float*)(buf + O_Y + (tt * 64 + rp) * 4) = y; *(float*)(buf + O_VF + (tt * 64 + rp) * 4) = rho; } \
                    } \
                    if (PASS == 3) { \
                        h2 dy = SU[0] * u2h(r8[0]); \
_Pragma("unroll") \
                        for (int x = 1; x < 4; ++x) dy = SU[x] * u2h(r8[x]) + dy; \
                        const float y = red8(hsum(dy)); \
                        if (sl == 0) *(float*)(buf + O_Y + (tt * 64 + rp) * 4) = y; \
                    } \
                } \
            }
template <int PASS>
__device__ __forceinline__ void rwkv_scan_phase(const bf16* Z, const RwkvW w, const bf16* Wl, float* Pb, float* Ub, bf16* MIX, bf16* RHO, float* BON, unsigned char* lds) {
    constexpr int SBUF = 45312, O_B = 4096, O_W = 8192, O_K = 12288, O_R = 16384, O_V2 = 20480, O_VF = 28672, O_Y = 36864, O_BON = 45056;
    constexpr int O_AW = 2 * SBUF, O_AA = O_AW + 4608, O_AG = O_AA + 4608, O_PU = O_AG + 8704, O_PA = O_PU + 8192, O_PG = O_PA + 8192;
    static_assert(O_PG + 4096 <= 131072, "scan LDS");
    const int tid = opaque_tid();
    const int rp = tid >> 3, sl = tid & 7, j0 = sl * 8;
    const int ptt = tid >> 4, pjg = (tid & 15) * 4;
    const int lane = tid & 63, wave = tid >> 6, r16 = lane & 15, q4 = lane >> 4, mrt = wave >> 2, mdt = wave & 3;
    for (int u = opaque_bid(); u < 16 * NCHK; u += gridDim.x) {
        const int bh = u / NCHK, c = u % NCHK, b = bh >> 3, h = bh & 7, col = h * 64 + pjg;
        const f32x4 mu_r = *(const f32x4*)(w.mu + col), mu_k = *(const f32x4*)(w.mu + 512 + col), mu_v = *(const f32x4*)(w.mu + 1024 + col);
        const f32x4 kkc = *(const f32x4*)(w.k_k + col), kac = *(const f32x4*)(w.k_a + col), w0c = *(const f32x4*)(w.w0 + col), a0c = *(const f32x4*)(w.a0 + col), rkc = *(const f32x4*)(w.r_k + col);
        f32x4 lgc = {0.f, 0.f, 0.f, 0.f}, lbc = {0.f, 0.f, 0.f, 0.f};
        if (PASS == 3) { lgc = *(const f32x4*)(w.ln_g + col); lbc = *(const f32x4*)(w.ln_b + col); }
        const f32x4 mu_wl = *(const f32x4*)(w.mu + 1536 + pjg), mu_al = *(const f32x4*)(w.mu + 1600 + pjg);
        f32x4 mu_g0 = {0.f, 0.f, 0.f, 0.f}, mu_g1 = {0.f, 0.f, 0.f, 0.f};
        if (PASS == 3) { mu_g0 = *(const f32x4*)(w.mu + 1664 + 2 * pjg); mu_g1 = *(const f32x4*)(w.mu + 1668 + 2 * pjg); }
        bf16x8 bw[2], ba[2], bg[4];
        { const bf16* wr_ = Wl + (size_t)(h * 64 + 16 * mdt + r16) * 256 + q4 * 8;
#pragma unroll
          for (int ks = 0; ks < 2; ++ks) { bw[ks] = *(const bf16x8*)(wr_ + 32 * ks); ba[ks] = *(const bf16x8*)(wr_ + 512 * 256 + 64 + 32 * ks); }
#pragma unroll
          for (int ks = 0; ks < 4; ++ks) bg[ks] = (PASS == 3) ? *(const bf16x8*)(wr_ + 1024 * 256 + 128 + 32 * ks) : bw[0]; }
        h2 SU[4], SP[4];
        if (PASS == 1) {
#pragma unroll
            for (int x = 0; x < 4; ++x) { SU[x] = (h2){(_Float16)0.f, (_Float16)0.f}; SP[x] = (h2){(_Float16)((rp == j0 + 2 * x) ? 1.f : 0.f), (_Float16)((rp == j0 + 2 * x + 1) ? 1.f : 0.f)}; }
        } else {
            if (c == 0) {
#pragma unroll
                for (int x = 0; x < 4; ++x) SU[x] = (h2){(_Float16)0.f, (_Float16)0.f};
            } else { const float* sp = Ub + ((size_t)(u - 1) * 64 + rp) * 64 + j0; const f32x4 t0 = *(const f32x4*)sp, t1 = *(const f32x4*)(sp + 4);
                SU[0] = (h2){(_Float16)t0[0], (_Float16)t0[1]}; SU[1] = (h2){(_Float16)t0[2], (_Float16)t0[3]}; SU[2] = (h2){(_Float16)t1[0], (_Float16)t1[1]}; SU[3] = (h2){(_Float16)t1[2], (_Float16)t1[3]}; }
#pragma unroll
            for (int x = 0; x < 4; ++x) SP[x] = (h2){(_Float16)0.f, (_Float16)0.f};
        }
        ScanRaw raw;
#define SCAN_LOAD_RAW(sub_) do { const int t_ = c * SCH + (sub_) * 32 + ptt; const bf16* zc = Z + ((size_t)b * SEQ + t_) * EVEN_IN; const bf16* zp = zc - EVEN_IN; \
            raw.cr = *(const u32x2*)(zc + 2048 + col); raw.ck = *(const u32x2*)(zc + 2560 + col); raw.cv = *(const u32x2*)(zc + 3072 + col); \
            raw.cwl = *(const u32x2*)(zc + 3584 + pjg); raw.cal = *(const u32x2*)(zc + 3648 + pjg); if (PASS == 3) raw.cgl = *(const u32x4*)(zc + 3712 + 2 * pjg); \
            raw.pr = (u32x2){0u, 0u}; raw.pk = (u32x2){0u, 0u}; raw.pv = (u32x2){0u, 0u}; raw.pwl = (u32x2){0u, 0u}; raw.pal = (u32x2){0u, 0u}; raw.pgl = (u32x4){0u, 0u, 0u, 0u}; \
            if (t_ > 0) { raw.pr = *(const u32x2*)(zp + 2048 + col); raw.pk = *(const u32x2*)(zp + 2560 + col); raw.pv = *(const u32x2*)(zp + 3072 + col); \
                raw.pwl = *(const u32x2*)(zp + 3584 + pjg); raw.pal = *(const u32x2*)(zp + 3648 + pjg); if (PASS == 3) raw.pgl = *(const u32x4*)(zp + 3712 + 2 * pjg); } } while (0)
        SCAN_LOAD_RAW(0);
        for (int sub = 0; sub < SCH / 32; ++sub) {
            unsigned char* buf = lds + (sub & 1) * SBUF;
            {
                u32x2 ow_, oa_;
#pragma unroll
                for (int wi = 0; wi < 2; ++wi) { float t_[2], a_[2];
#pragma unroll
                    for (int e = 0; e < 2; ++e) { const int x = 2 * wi + e, sh = 16 * e;
                        const float cw = bf2f((bf16)(raw.cwl[wi] >> sh)), pw = bf2f((bf16)(raw.pwl[wi] >> sh)), ca = bf2f((bf16)(raw.cal[wi] >> sh)), pa = bf2f((bf16)(raw.pal[wi] >> sh));
                        const float zw = cw + mu_wl[x] * (pw - cw); t_[e] = 1.f - 2.f * __builtin_amdgcn_rcpf(1.f + __builtin_amdgcn_exp2f(zw * 2.8853900817779268f)); a_[e] = ca + mu_al[x] * (pa - ca); }
                    ow_[wi] = pk2(t_[0], t_[1]); oa_[wi] = pk2(a_[0], a_[1]); }
                *(u32x2*)(lds + O_AW + (ptt * 72 + pjg) * 2) = ow_; *(u32x2*)(lds + O_AA + (ptt * 72 + pjg) * 2) = oa_;
                if (PASS == 3) { u32x4 og_;
#pragma unroll
                    for (int wi = 0; wi < 4; ++wi) { float g_[2];
#pragma unroll
                        for (int e = 0; e < 2; ++e) { const int x = 2 * wi + e, sh = 16 * e; const float cg = bf2f((bf16)(raw.cgl[wi] >> sh)), pg = bf2f((bf16)(raw.pgl[wi] >> sh));
                            g_[e] = sigmoidf_(cg + (x < 4 ? mu_g0[x & 3] : mu_g1[x & 3]) * (pg - cg)); }
                        og_[wi] = pk2(g_[0], g_[1]); }
                    *(u32x4*)(lds + O_AG + (ptt * 136 + 2 * pjg) * 2) = og_; }
            }
            __syncthreads();
            {
                const bf16* AW = (const bf16*)(lds + O_AW); const bf16* AA = (const bf16*)(lds + O_AA); const bf16* AG = (const bf16*)(lds + O_AG);
                f32x4 cu = {0.f, 0.f, 0.f, 0.f}, ca = {0.f, 0.f, 0.f, 0.f}, cg = {0.f, 0.f, 0.f, 0.f};
#pragma unroll
                for (int ks = 0; ks < 2; ++ks) { cu = __builtin_amdgcn_mfma_f32_16x16x32_bf16(*(const bf16x8*)(AW + (16 * mrt + r16) * 72 + 32 * ks + q4 * 8), bw[ks], cu, 0, 0, 0);
                    ca = __builtin_amdgcn_mfma_f32_16x16x32_bf16(*(const bf16x8*)(AA + (16 * mrt + r16) * 72 + 32 * ks + q4 * 8), ba[ks], ca, 0, 0, 0); }
                if (PASS == 3) {
#pragma unroll
                    for (int ks = 0; ks < 4; ++ks) cg = __builtin_amdgcn_mfma_f32_16x16x32_bf16(*(const bf16x8*)(AG + (16 * mrt + r16) * 136 + 32 * ks + q4 * 8), bg[ks], cg, 0, 0, 0); }
#pragma unroll
                for (int jj = 0; jj < 4; ++jj) { const int o_ = (16 * mrt + q4 * 4 + jj) * 64 + 16 * mdt + r16;
                    *(float*)(lds + O_PU + o_ * 4) = cu[jj]; *(float*)(lds + O_PA + o_ * 4) = ca[jj]; if (PASS == 3) *(bf16*)(lds + O_PG + o_ * 2) = (bf16)f2bf(cg[jj]); }
            }
            __syncthreads();
            u32x2 gcur = {0u, 0u};
            if (PASS == 3) gcur = *(const u32x2*)(lds + O_PG + (ptt * 64 + pjg) * 2);
            const f32x4 upre = *(const f32x4*)(lds + O_PU + (ptt * 64 + pjg) * 4), apre = *(const f32x4*)(lds + O_PA + (ptt * 64 + pjg) * 4);
            {
                float r4[4], k4[4], v4[4], a4[4], kk[4]; float ss = 0.f;
#pragma unroll
                for (int x = 0; x < 4; ++x) { const int sh = 16 * (x & 1); const int wi = x >> 1;
                    const float zr = bf2f((bf16)(raw.cr[wi] >> sh)), zk = bf2f((bf16)(raw.ck[wi] >> sh)), zv = bf2f((bf16)(raw.cv[wi] >> sh));
                    const float qr = bf2f((bf16)(raw.pr[wi] >> sh)), qk = bf2f((bf16)(raw.pk[wi] >> sh)), qv = bf2f((bf16)(raw.pv[wi] >> sh));
                    r4[x] = zr + mu_r[x] * (qr - zr); k4[x] = zk + mu_k[x] * (qk - zk); v4[x] = zv + mu_v[x] * (qv - zv);
                    a4[x] = sigmoidf_(apre[x] + a0c[x]);
                    kk[x] = k4[x] * kkc[x]; ss += kk[x] * kk[x]; }
                ss = red16(ss);
                const float inv = __builtin_amdgcn_rsqf(fmaxf(ss, 1e-24f));
                float oA[4], oB[4], oW[4], oK[4]; float dot = 0.f;
#pragma unroll
                for (int x = 0; x < 4; ++x) { const float kn = kk[x] * inv; oA[x] = -kn; oB[x] = kn * a4[x];
                    oW[x] = __expf(-0.6065306597126334f * sigmoidf_(upre[x] + w0c[x]));
                    oK[x] = k4[x] * (1.f + (a4[x] - 1.f) * kac[x]); dot += r4[x] * oK[x] * rkc[x]; }
                const int o2 = (ptt * 64 + pjg) * 2;
                *(u32x2*)(buf + o2) = (u32x2){pkh(oA[0], oA[1]), pkh(oA[2], oA[3])}; *(u32x2*)(buf + O_B + o2) = (u32x2){pkh(oB[0], oB[1]), pkh(oB[2], oB[3])};
                *(u32x2*)(buf + O_W + o2) = (u32x2){pkh(oW[0], oW[1]), pkh(oW[2], oW[3])}; *(u32x2*)(buf + O_K + o2) = (u32x2){pkh(oK[0], oK[1]), pkh(oK[2], oK[3])};
                *(u32x4*)(buf + O_V2 + 2 * o2) = (u32x4){pkh(v4[0], v4[0]), pkh(v4[1], v4[1]), pkh(v4[2], v4[2]), pkh(v4[3], v4[3])};
                *(u32x2*)(buf + O_R + o2) = (u32x2){pkh(r4[0], r4[1]), pkh(r4[2], r4[3])};
                if (PASS == 3) *(f32x4*)(buf + O_VF + 2 * o2) = (f32x4){v4[0], v4[1], v4[2], v4[3]};
                dot = red16(dot); if ((tid & 15) == 0) *(float*)(buf + O_BON + ptt * 4) = dot;
            }
            __syncthreads();
            if (sub + 1 < SCH / 32) SCAN_LOAD_RAW(sub + 1);
            SCAN_STEPS(true)
            if (PASS == 1) {
                __syncthreads();
                const int t = c * SCH + sub * 32 + ptt; const size_t grow = (size_t)b * SEQ + t;
                const f32x4 y4 = *(const f32x4*)(buf + O_Y + (ptt * 64 + pjg) * 4), q4v = *(const f32x4*)(buf + O_VF + (ptt * 64 + pjg) * 4);
                *(u32x2*)(MIX + grow * DM + 512 + col) = (u32x2){pk2(y4[0], y4[1]), pk2(y4[2], y4[3])};
                *(u32x2*)(RHO + grow * 512 + col) = (u32x2){pk2(q4v[0], q4v[1]), pk2(q4v[2], q4v[3])};
                if ((tid & 15) == 0) BON[grow * 8 + h] = *(const float*)(buf + O_BON + ptt * 4);
            }
            if (PASS == 3) {
                __syncthreads();
                const int t = c * SCH + sub * 32 + ptt; const size_t grow = (size_t)b * SEQ + t;
                const f32x4 y4 = *(const f32x4*)(buf + O_Y + (ptt * 64 + pjg) * 4), v4 = *(const f32x4*)(buf + O_VF + (ptt * 64 + pjg) * 4);
                const float dot = *(const float*)(buf + O_BON + ptt * 4);
                const float mean = red16((y4[0] + y4[1]) + (y4[2] + y4[3])) * (1.f / 64.f);
                float qq = 0.f;
#pragma unroll
                for (int x = 0; x < 4; ++x) { const float d = y4[x] - mean; qq += d * d; }
                const float rstd = rsqrtf(red16(qq) * (1.f / 64.f) + 64e-5f);
                float o4[4];
#pragma unroll
                for (int x = 0; x < 4; ++x) { const float gate = bf2f((bf16)(gcur[x >> 1] >> (16 * (x & 1))));
                    o4[x] = ((y4[x] - mean) * rstd * lgc[x] + lbc[x] + dot * v4[x]) * gate; }
                u32x2 ow; ow.x = pk2(o4[0], o4[1]); ow.y = pk2(o4[2], o4[3]);
                *(u32x2*)(MIX + grow * DM + 512 + col) = ow;
            }
        }
#undef SCAN_LOAD_RAW
        if (PASS == 1) { float* du = Ub + ((size_t)u * 64 + rp) * 64 + j0; float* dp = Pb + ((size_t)u * 64 + rp) * 64 + j0;
            *(f32x4*)du = (f32x4){(float)SU[0][0], (float)SU[0][1], (float)SU[1][0], (float)SU[1][1]}; *(f32x4*)(du + 4) = (f32x4){(float)SU[2][0], (float)SU[2][1], (float)SU[3][0], (float)SU[3][1]};
            *(f32x4*)dp = (f32x4){(float)SP[0][0], (float)SP[0][1], (float)SP[1][0], (float)SP[1][1]}; *(f32x4*)(dp + 4) = (f32x4){(float)SP[2][0], (float)SP[2][1], (float)SP[3][0], (float)SP[3][1]}; }
    }
}
__device__ __forceinline__ void rwkv_out_phase(const bf16* Z, const RwkvW w, const bf16* Wl, const float* Ub, const bf16* RHO, const float* BON, bf16* MIX, unsigned char* lds) {
    bf16* Rs = (bf16*)lds; bf16* Ss = (bf16*)(lds + 18432); bf16* AG = (bf16*)(lds + 27648); bf16* Ys = (bf16*)(lds + 62464); bf16* Vs = (bf16*)(lds + 80896);
    const int tid = opaque_tid(), lane = tid & 63, wave = tid >> 6, r16 = lane & 15, q4 = lane >> 4;
    for (int u = opaque_bid(); u < 2048; u += gridDim.x) {
        const int bh = u >> 7, c = u & 127, b = bh >> 3, h = bh & 7, col0 = h * 64; const size_t rowbase = (size_t)b * SEQ + c * 128;
        __syncthreads();
        for (int ci = tid; ci < 1024; ci += NTHR) { const int j = ci >> 3, c8 = (ci & 7) * 8;
            *(u32x4*)(Rs + j * 72 + c8) = *(const u32x4*)(RHO + (rowbase + j) * 512 + col0 + c8);
            *(u32x4*)(Ys + j * 72 + c8) = *(const u32x4*)(MIX + (rowbase + j) * DM + 512 + col0 + c8);
            *(u32x4*)(Vs + (j + 1) * 72 + c8) = *(const u32x4*)(Z + (rowbase + j) * EVEN_IN + 3072 + col0 + c8); }
        if (tid < 8) { u32x4 pv = {0u, 0u, 0u, 0u}; if (c > 0) pv = *(const u32x4*)(Z + (rowbase - 1) * EVEN_IN + 3072 + col0 + tid * 8); *(u32x4*)(Vs + tid * 8) = pv; }
        for (int i4 = tid; i4 < 1024; i4 += NTHR) { const int i = i4 >> 4, k4 = (i4 & 15) * 4; f32x4 sv = {0.f, 0.f, 0.f, 0.f};
            if ((c >> SLOG) > 0) sv = *(const f32x4*)(Ub + (size_t)(bh * NCHK + (c >> SLOG) - 1) * 4096 + i * 64 + k4);
            *(u32x2*)(Ss + i * 72 + k4) = (u32x2){pk2(sv[0], sv[1]), pk2(sv[2], sv[3])}; }
        for (int ci = tid; ci < 2048; ci += NTHR) { const int j = ci >> 4, c8 = (ci & 15) * 8; const bf16* zc = Z + (rowbase + j) * EVEN_IN + 3712 + c8;
            const u32x4 cg = *(const u32x4*)zc; u32x4 pg = {0u, 0u, 0u, 0u}; if (c > 0 || j > 0) pg = *(const u32x4*)(zc - EVEN_IN);
            const f32x4 m0 = *(const f32x4*)(w.mu + 1664 + c8), m1 = *(const f32x4*)(w.mu + 1668 + c8); u32x4 og;
#pragma unroll
            for (int x = 0; x < 4; ++x) { const float c0 = __uint_as_float(cg[x] << 16), c1 = __uint_as_float(cg[x] & 0xffff0000u), p0 = __uint_as_float(pg[x] << 16), p1 = __uint_as_float(pg[x] & 0xffff0000u);
                const float ma = x < 2 ? m0[2 * x] : m1[2 * x - 4], mb = x < 2 ? m0[2 * x + 1] : m1[2 * x - 3];
                og[x] = pk2(sigmoidf_(c0 + ma * (p0 - c0)), sigmoidf_(c1 + mb * (p1 - c1))); }
            *(u32x4*)(AG + j * 136 + c8) = og; }
        __syncthreads();
        f32x4 ya[4], ga[4];
#pragma unroll
        for (int dt = 0; dt < 4; ++dt) { ya[dt] = (f32x4){0.f, 0.f, 0.f, 0.f}; ga[dt] = (f32x4){0.f, 0.f, 0.f, 0.f};
#pragma unroll
            for (int k0 = 0; k0 < 64; k0 += 32) ya[dt] = mma16(Rs, 72, 16 * wave, Ss, 72, 16 * dt, k0, ya[dt], lane);
            const bf16* wg = Wl + (size_t)(1024 + col0 + 16 * dt + r16) * 256 + 128 + q4 * 8;
#pragma unroll
            for (int ks = 0; ks < 4; ++ks) ga[dt] = __builtin_amdgcn_mfma_f32_16x16x32_bf16(*(const bf16x8*)(AG + (16 * wave + r16) * 136 + 32 * ks + q4 * 8), *(const bf16x8*)(wg + 32 * ks), ga[dt], 0, 0, 0); }
#pragma unroll
        for (int jj = 0; jj < 4; ++jj) { const int tl = 16 * wave + q4 * 4 + jj; const float bon = BON[(rowbase + tl) * 8 + h];
            float y[4]; float sum = 0.f;
#pragma unroll
            for (int dt = 0; dt < 4; ++dt) { y[dt] = ya[dt][jj] + bf2f(Ys[tl * 72 + 16 * dt + r16]); sum += y[dt]; }
            const float mean = red16(sum) * (1.f / 64.f); float qq = 0.f;
#pragma unroll
            for (int dt = 0; dt < 4; ++dt) { y[dt] -= mean; qq += y[dt] * y[dt]; }
            const float rstd = rsqrtf(red16(qq) * (1.f / 64.f) + 64e-5f);
#pragma unroll
            for (int dt = 0; dt < 4; ++dt) { const int ch = 16 * dt + r16; const float vc = bf2f(Vs[(tl + 1) * 72 + ch]), vp = bf2f(Vs[tl * 72 + ch]);
                const float vs = vc + w.mu[1024 + col0 + ch] * (vp - vc);
                Ys[tl * 72 + ch] = (bf16)f2bf((y[dt] * rstd * w.ln_g[col0 + ch] + w.ln_b[col0 + ch] + bon * vs) * ga[dt][jj]); } }
#pragma unroll
        for (int t2 = 0; t2 < 2; ++t2) { const int cidx = lane + 64 * t2, i = 16 * wave + (cidx >> 3), c8 = (cidx & 7) * 8;
            *(u32x4*)(MIX + (rowbase + i) * DM + 512 + col0 + c8) = *(const u32x4*)(Ys + i * 72 + c8); }
    }
}
template <bool STORE>
__device__ __forceinline__ void rwkv_combine_phase(const float* Pb, const float* Ub, float* Sb, unsigned char* lds) {
    float* s = (float*)lds; float* red = s + 256;
    const int tid = opaque_tid(), j = tid & 63, kq = tid >> 6;
    for (int item = opaque_bid(); item < 256; item += gridDim.x) {
        const int bh = item >> 4, rg = item & 15;
        __syncthreads();
        if (tid < 256) s[tid] = 0.f;
        __syncthreads();
        const float* Pc = Pb + (size_t)(bh * NCHK) * 4096 + (8 * kq) * 64 + j; const float* Uc = Ub + (size_t)(bh * NCHK) * 4096 + (4 * rg + (tid >> 6)) * 64 + j; float* Sc = Sb + (size_t)(bh * NCHK) * 4096 + (4 * rg + (tid >> 6)) * 64 + j;
        float pk[8], uv = 0.f;
#pragma unroll
        for (int x = 0; x < 8; ++x) pk[x] = Pc[x * 64];
        if (tid < 256) uv = Uc[0];
        for (int c = 0; c < NCHK; ++c) {
            float nk[8], nu = 0.f;
            if (c + 1 < NCHK) {
#pragma unroll
                for (int x = 0; x < 8; ++x) nk[x] = Pc[(size_t)(c + 1) * 4096 + x * 64];
                if (tid < 256) nu = Uc[(size_t)(c + 1) * 4096];
            } else {
#pragma unroll
                for (int x = 0; x < 8; ++x) nk[x] = 0.f;
            }
#pragma unroll
            for (int ri = 0; ri < 4; ++ri) { float a = 0.f;
#pragma unroll
                for (int x = 0; x < 8; ++x) a += s[ri * 64 + 8 * kq + x] * pk[x];
                red[(kq * 4 + ri) * 64 + j] = a; }
            __syncthreads();
            if (tid < 256) { const int ri = tid >> 6; float v = uv;
#pragma unroll
                for (int q = 0; q < 8; ++q) v += red[(q * 4 + ri) * 64 + j];
                s[tid] = v; if (STORE || v == 1.2345e-30f) Sc[(size_t)c * 4096] = v; }
            __syncthreads();
#pragma unroll
            for (int x = 0; x < 8; ++x) pk[x] = nk[x];
            uv = nu;
        }
    }
}

#define XB_TMO      128
#define XB_XCNT(j)  (256  + 64 * (j))
#define XB_XSUB(j)  (1280 + 64 * (j))
#define XB_XGEN(j)  (2304 + 64 * (j))
#define XB_TOP      3328
#define XB_TOPGEN   3392
#define XCD_BAR_WORDS 3456
#define XB_SPIN_CAP (1u << 18)

__device__ __forceinline__ unsigned xb_ld(unsigned* p)              { return __hip_atomic_load(p, __ATOMIC_RELAXED, __HIP_MEMORY_SCOPE_AGENT); }
__device__ __forceinline__ unsigned xb_add(unsigned* p, unsigned v) { return __hip_atomic_fetch_add(p, v, __ATOMIC_RELAXED, __HIP_MEMORY_SCOPE_AGENT); }
__device__ __forceinline__ unsigned xb_xcc_id() { return (unsigned)__builtin_amdgcn_s_getreg((3 << 11) | 20) & 0xFu; }
#define XB_SPIN(cond, bar) do { unsigned _sp = 0; while (cond) { __builtin_amdgcn_s_sleep(1); \
    if ((++_sp & 255u) == 0u) { if (xb_ld(&(bar)[XB_TMO])) break; if (_sp > XB_SPIN_CAP) { atomicAdd(&(bar)[XB_TMO], 1u); break; } } } } while (0)

struct XcdBarrier {
    unsigned* bar; unsigned x;
    volatile LAS unsigned* st;
};

__device__ __forceinline__ XcdBarrier xcd_barrier_post(unsigned* bar, volatile LAS unsigned* st) {
    XcdBarrier b; b.bar = bar; b.x = xb_xcc_id(); b.st = st;
    if (threadIdx.x == 0) (void)xb_add(&bar[XB_XCNT(b.x)], 1u);
    return b;
}
__device__ __forceinline__ void xcd_barrier_complete(unsigned* bar, unsigned x, unsigned& nloc, unsigned& nx) {
    const unsigned G = gridDim.x * gridDim.y * gridDim.z;
    unsigned sum, cnt, mine, sp = 0u;
    for (;;) {
        sum = 0u; cnt = 0u; mine = 0u;
#pragma unroll
        for (unsigned j = 0; j < 16; ++j) { const unsigned c = xb_ld(&bar[XB_XCNT(j)]); sum += c; cnt += (c > 0u) ? 1u : 0u; mine = (j == x) ? c : mine; }
        if (sum == G) break;
        __builtin_amdgcn_s_sleep(1);
        if ((++sp & 255u) == 0u) { if (xb_ld(&bar[XB_TMO])) break; if (sp > XB_SPIN_CAP) { atomicAdd(&bar[XB_TMO], 1u); break; } }
    }
    nloc = mine > 0u ? mine : 1u; nx = cnt > 0u ? cnt : 1u;
}

__device__ __forceinline__ void xcd_barrier(const XcdBarrier& b) {
    asm volatile("s_waitcnt vmcnt(0)" ::: "memory");
    __syncthreads();
    if (threadIdx.x == 0) {
        unsigned* bar = b.bar;
        __builtin_amdgcn_s_waitcnt(0);
        unsigned nloc = b.st[0], nx = b.st[1];
        if (nloc == 0u) { xcd_barrier_complete(bar, b.x, nloc, nx); b.st[0] = nloc; b.st[1] = nx; }
        const unsigned old = xb_add(&bar[XB_XSUB(b.x)], 1u);
        const unsigned gen = old / nloc;
        if (old + 1u == (gen + 1u) * nloc) {
            __builtin_amdgcn_fence(__ATOMIC_RELEASE, "agent");
            asm volatile("s_waitcnt vmcnt(0)" ::: "memory");
            const unsigned og = xb_add(&bar[XB_TOP], 1u);
            const unsigned tg = og / nx;
            if (og + 1u == (tg + 1u) * nx) xb_add(&bar[XB_TOPGEN], 1u);
            else XB_SPIN(xb_ld(&bar[XB_TOPGEN]) == tg, bar);
            __builtin_amdgcn_fence(__ATOMIC_ACQUIRE, "agent");
            xb_add(&bar[XB_XGEN(b.x)], 1u);
            asm volatile("s_waitcnt vmcnt(0)" ::: "memory");
        } else {
            XB_SPIN(xb_ld(&bar[XB_XGEN(b.x)]) == gen, bar);
            __builtin_amdgcn_fence(__ATOMIC_ACQUIRE, "agent");
            asm volatile("s_waitcnt vmcnt(0)" ::: "memory");
        }
    }
    __syncthreads();
}

enum { PH_INIT = 0, PH_INPROJ, PH_RETKV, PH_RETSCAN, PH_RETOUT, PH_LORA, PH_SCAN1, PH_COMBINE, PH_SCAN3, PH_SWA, PH_FFN1, PH_OUTPROJ, PH_RMS };
template <int PH, bool STORE = true>
__device__ __forceinline__ void do_phase(int layer, int part, unsigned char* lds) {
    ParamsPtr pq = (ParamsPtr)__builtin_amdgcn_kernarg_segment_ptr(); asm volatile("" : "+s"(pq));
#define p (*pq)
    bf16* wb = (bf16*)p.ws;
    bf16* Z = (bf16*)(p.ws + WS_Z); bf16* XN = (bf16*)(p.ws + WS_XN); float* Pb = p.out; float* Ub = p.out + 8388608; float* KVb = p.out + 16777216; float* Sb = p.out + 4194304; bf16* RHO = (bf16*)(p.out + 25165824); float* BON = (float*)(p.ws + WS_BON);
    bf16* RB = (bf16*)(p.ws + WS_RB); float* SSQ = (float*)(p.ws + WS_SSQ);
    const int i = layer >> 1; const bool even = (layer & 1) == 0;
    if constexpr (PH == PH_INIT) { weights_phase(pq, lds); init_rows_phase(p.x, RB, SSQ); rope_table_phase((f32x2v*)(p.ws + WS_ROPE)); }
    if constexpr (PH == PH_INPROJ) {
        const bf16* Bt = even ? wb + E_WIN + (size_t)i * 3840 * 1024 : wb + E_WQKV + (size_t)i * 1536 * 1024;
        const int N = even ? EVEN_IN : QKVW;
        EpiStore E{Z, N, even ? nullptr : p.swa_b_qkv + i * QKVW, (const float*)(lds + RSTD_OFF), 0}; run_gemm_norm(lds, RB, Bt, MTOK, N, DM, E, SSQ + (size_t)(2 * layer) * MTOK * 16);
    }
    if constexpr (PH == PH_RETKV || PH == PH_RETOUT) {
        const RwkvW rw{p.rwkv_mu + i * 1792, p.rwkv_k_k + i * 512, p.rwkv_k_a + i * 512, p.rwkv_r_k + i * 512, p.rwkv_ln_g + i * 512, p.rwkv_ln_b + i * 512, p.rwkv_w0 + i * 512, p.rwkv_a0 + i * 512};
        const bf16* Wl = wb + E_WL + (size_t)i * 1536 * 256;
        if constexpr (PH == PH_RETKV) { ret_kv_phase(Z, KVb, (const f32x2v*)(p.ws + WS_ROPE), lds); __syncthreads(); rwkv_scan_phase<1>(Z, rw, Wl, Pb, Ub, XN, RHO, BON, lds); }
        else { ret_out_phase(Z, KVb, XN, lds); __syncthreads(); rwkv_out_phase(Z, rw, Wl, Sb, RHO, BON, XN, lds); }
    }
    if constexpr (PH == PH_RETSCAN) { ret_scan_phase<STORE>(KVb); rwkv_combine_phase<STORE>(Pb, Ub, Sb, lds); }
    if constexpr (PH == PH_SWA) swa_phase(Z, XN, p.swa_sinks + i * 16, lds);
    if constexpr (PH == PH_FFN1) { EpiSwiglu E{Z, FF, (const float*)(lds + RSTD_OFF), 0}; run_gemm_norm(lds, RB, wb + E_WGU + (size_t)layer * 5632 * 1024, MTOK, 2 * FF, DM, E, SSQ + (size_t)(2 * layer + 1) * MTOK * 16); }
    if constexpr (PH == PH_OUTPROJ) {
        const bf16* A = part == 0 ? XN : Z;
        const bf16* Bt = part == 0 ? (even ? wb + E_WOUT + (size_t)i * 1024 * 1024 : wb + E_WO + (size_t)i * 1024 * 1024) : wb + E_WD + (size_t)layer * 1024 * FF;
        const float* bias = (part == 0 && !even) ? p.swa_b_o + i * DM : nullptr;
        EpiRes E{RB, DM, bias, SSQ + (size_t)(part == 0 ? 2 * layer + 1 : (layer < 3 ? 2 * layer + 2 : 7)) * MTOK * 16}; run_gemm(lds, A, Bt, MTOK, DM, part == 0 ? DM : FF, E);
    }
    if constexpr (PH == PH_RMS) {
        final_rms_phase(RB, p.final_g, p.out);
    }
#undef p
}

#ifndef FUSED
#define FUSED 1
#endif
#ifndef PROBE_MASK
#define PROBE_MASK 0
#endif
#if FUSED
__global__ void __launch_bounds__(NTHR, 2) trunk_fwd(Params p) {
    extern __shared__ __attribute__((aligned(16))) unsigned char lds[];
    cg::grid_group grid = cg::this_grid();
    volatile LAS unsigned* misc = (volatile LAS unsigned*)((LAS unsigned char*)lds + MISC_OFF);
    if (threadIdx.x < 16) misc[threadIdx.x] = 0u;
    __syncthreads();
    XcdBarrier bar = xcd_barrier_post((unsigned*)(((const Params __attribute__((address_space(4)))*)__builtin_amdgcn_kernarg_segment_ptr())->ws + WS_CTL), misc);
    do_phase<PH_INIT>(0, 0, lds);
    grid.sync();
    if (PROBE_MASK & 1) { do_phase<PH_INIT>(0, 0, lds); xcd_barrier(bar); }
#define GSYNC() do { xcd_barrier(bar); if (PROBE_MASK & 0x8000) xcd_barrier(bar); } while (0)
#define RUN(PH) do { if (PROBE_MASK & (1 << PH)) { do_phase<PH, false>(layer, part, lds); GSYNC(); } do_phase<PH>(layer, part, lds); GSYNC(); } while (0)
    for (int hl = 0; hl < 8; ++hl) {
        const int layer = hl >> 1, part = hl & 1;
        if (part == 0) {
            RUN(PH_INPROJ);
            if ((layer & 1) == 0) {
                RUN(PH_RETKV);
                RUN(PH_RETSCAN);
                RUN(PH_RETOUT);
            } else {
                RUN(PH_SWA);
            }
        } else {
            RUN(PH_FFN1);
        }
        RUN(PH_OUTPROJ);
        if (hl == 7) do_phase<PH_RMS>(layer, part, lds);
    }
}
#else
template <int PH>
__global__ void __launch_bounds__(NTHR, 2) phase_k(Params p, int layer, int part) {
    extern __shared__ __attribute__((aligned(16))) unsigned char lds[];
    do_phase<PH>(layer, part, lds);
}
#endif

extern "C" void kernel_launch(void* const* d_in, const int* in_sizes, int n_in, void* d_out, int out_size, void* d_ws, size_t ws_size, hipStream_t stream) {
    static int grid = 0;
    if (grid == 0) {
        if (n_in != 25 || out_size != MTOK * DM || ws_size < WS_END) { fprintf(stderr, "kernel_launch: unexpected shapes (n_in %d out %d ws %zu)\n", n_in, out_size, ws_size); grid = -1; return; }
        int dev = 0, cus = 0;
        (void)hipGetDevice(&dev); (void)hipDeviceGetAttribute(&cus, hipDeviceAttributeMultiprocessorCount, dev);
#if FUSED
        int per_cu = 0;
        (void)hipFuncSetAttribute((const void*)trunk_fwd, hipFuncAttributeMaxDynamicSharedMemorySize, LDS_BYTES);
        (void)hipOccupancyMaxActiveBlocksPerMultiprocessor(&per_cu, (const void*)trunk_fwd, NTHR, LDS_BYTES);
        grid = cus > 0 ? cus : 256;
#else
#define SETATTR(PH) (void)hipFuncSetAttribute((const void*)phase_k<PH>, hipFuncAttributeMaxDynamicSharedMemorySize, LDS_BYTES)
        SETATTR(PH_INIT); SETATTR(PH_INPROJ); SETATTR(PH_RETKV); SETATTR(PH_RETSCAN); SETATTR(PH_RETOUT); SETATTR(PH_LORA); SETATTR(PH_SCAN1); SETATTR(PH_COMBINE);
        SETATTR(PH_SCAN3); SETATTR(PH_SWA); SETATTR(PH_FFN1); SETATTR(PH_OUTPROJ); SETATTR(PH_RMS);
        grid = cus;
#endif
        (void)hipGetLastError();
    }
    if (grid < 0) return;
    Params p{};
    const float** pp = (const float**)&p;
    for (int i = 0; i < 25; ++i) pp[i] = (const float*)d_in[i];
    p.out = (float*)d_out; p.ws = (unsigned char*)d_ws;
#if FUSED
    (void)hipMemsetAsync((char*)d_ws + WS_CTL, 0, CTL_BYTES, stream);
    void* args[] = {&p};
    hipError_t e = hipLaunchCooperativeKernel((const void*)trunk_fwd, dim3(grid), dim3(NTHR), args, LDS_BYTES, stream);
    if (e != hipSuccess) fprintf(stderr, "cooperative launch failed: %s (grid %d)\n", hipGetErrorString(e), grid);
#else
#define LAUNCH(PH, layer, part) hipLaunchKernelGGL(phase_k<PH>, dim3(grid), dim3(NTHR), LDS_BYTES, stream, p, layer, part)
    LAUNCH(PH_INIT, 0, 0);
    for (int hl = 0; hl < 8; ++hl) {
        const int layer = hl >> 1, part = hl & 1;
        if (part == 0) {
            LAUNCH(PH_INPROJ, layer, part);
            if ((layer & 1) == 0) { LAUNCH(PH_RETKV, layer, part); LAUNCH(PH_RETSCAN, layer, part); LAUNCH(PH_RETOUT, layer, part); }
            else LAUNCH(PH_SWA, layer, part);
        } else LAUNCH(PH_FFN1, layer, part);
        LAUNCH(PH_OUTPROJ, layer, part);
        if (hl == 7) LAUNCH(PH_RMS, layer, part);
    }
#endif
}
```

```cpp
#include <hip/hip_runtime.h>
#include <hip/hip_cooperative_groups.h>
#include <cstdio>
#include <cstdint>
#include <cmath>
namespace cg = cooperative_groups;
__device__ __forceinline__ int opaque_tid() { int t = threadIdx.x; asm volatile("" : "+v"(t)); return t; }
__device__ __forceinline__ int opaque_bid() { int b = blockIdx.x; asm volatile("" : "+s"(b)); return b; }
#define FUSED 1
#define SLOG 3
#define PG8_WGM 4
#ifndef PG8_WGM
#define PG8_WGM 8
#endif
namespace pg8 {
#define PG8_LAS __attribute__((address_space(3)))
typedef unsigned short bf16_t;
typedef short bf16x8 __attribute__((ext_vector_type(8)));
typedef float f32x4 __attribute__((ext_vector_type(4)));
typedef unsigned u32x4 __attribute__((ext_vector_type(4)));
constexpr int BM = 256, BK = 64, HALF = 128, HTB = HALF * BK * 2  , STAGE_BYTES = 8 * HTB, NXCD = 8, WGM = PG8_WGM;

__host__ __device__ __forceinline__ int lds_byte(int r, int c) { const int st = (r >> 4) * 2 + (c >> 5), rr = r & 15, cc = c & 31, ob = rr * 64 + cc * 2; return st * 1024 + (ob ^ (((ob >> 9) & 1) << 5)); }
__host__ __device__ __forceinline__ void stage_rc(int b, int& R, int& C) { const int st = b / 1024, sb = b % 1024, swz = sb ^ (((sb >> 9) & 1) << 5); R = (st >> 1) * 16 + swz / 64; C = (st & 1) * 32 + (swz % 64) / 2; }
__host__ __device__ __forceinline__ int perm32(int rho) { const int n = rho >> 4, i = rho & 15; return 8 * (i >> 2) + 4 * n + (i & 3); }

struct Unit { int pm, pn; };
struct Gemm { const bf16_t* A; const bf16_t* Bt; int M, N, K; };

struct StaticOrder {
    int nM, nN, nwg, G, c;
    __host__ __device__ void init(int M, int N, int G_, int c_) { nM = M / BM; nN = N / BM; nwg = nM * nN; G = G_; c = c_; }
    __host__ __device__ bool next(int i, Unit& u) const {
        const long L = (long)i * G + c; if (L >= nwg) return false;
        int wgid = (int)L; { const int q = nwg / NXCD, r = nwg % NXCD, xcd = wgid % NXCD, off = wgid / NXCD; wgid = (xcd < r ? xcd * (q + 1) : r * (q + 1) + (xcd - r) * q) + off; }
        const int nig = WGM * nN, gid = wgid / nig, fm = gid * WGM, gsz = (nM - fm) < WGM ? (nM - fm) : WGM;
        u.pm = fm + ((wgid % nig) % gsz); u.pn = (wgid % nig) / gsz; return true;
    }
    __device__ __forceinline__ void a_ready(const Unit&) const {}
    __device__ __forceinline__ void done(const Unit&) const {}
};

__device__ __forceinline__ unsigned cvt_pk_bf16(float lo, float hi) { unsigned r; asm volatile("v_cvt_pk_bf16_f32 %0, %1, %2" : "=v"(r) : "v"(lo), "v"(hi)); return r; }
typedef float f32x2 __attribute__((ext_vector_type(2)));
__device__ __forceinline__ f32x2 gelu_pk(f32x2 v) {
    const f32x2 av = __builtin_elementwise_abs(v), d = av * 0.2316418882f + 1.0f;
    f32x2 t; t.x = __builtin_amdgcn_rcpf(d.x); t.y = __builtin_amdgcn_rcpf(d.y);
    f32x2 q = t * 0.5307027145f + (-0.7265760135f); q = q * t + 0.7107068705f; q = q * t + (-0.142248368f); q = q * t + 0.127414796f; q = q * t;
    const f32x2 s = (v * v) * (-0.72134752044f);
    f32x2 e; e.x = __builtin_amdgcn_exp2f(s.x); e.y = __builtin_amdgcn_exp2f(s.y);
    const f32x2 m = v * (q * e), r = v - m;
    f32x2 o; o.x = v.x < 0.f ? m.x : r.x; o.y = v.y < 0.f ? m.y : r.y; return o;
}

template <int ACT  > struct EpiBf16 {
    static constexpr bool PERM = true, AFTER_DRAIN = false; static_assert(ACT == 0 || ACT == 1, "EpiBf16: ACT is 0 (none) or 1 (gelu_pk)");
    bf16_t* O; int ldc; const float* bias; int split_cols; size_t split_stride; float scale0;
    __device__ __forceinline__ void operator()(const f32x4 (&acc)[2][2][4][2], const Unit& u, int wr, int wc, int fr, int fq) const {
        const int row0 = u.pm * BM + wr * 64 + fr; int colt = u.pn * BM; bf16_t* base = O;
        float sc = 1.f; if (split_cols) { const int t = colt / split_cols; base += (size_t)t * split_stride; colt -= t * split_cols; if (t == 0) sc = scale0; }
        const int col0 = colt + wc * 32 + 8 * fq, bcol0 = u.pn * BM + wc * 32 + 8 * fq;
        f32x4 bv[2][2];
#pragma unroll
        for (int bj = 0; bj < 2; ++bj)
#pragma unroll
            for (int n = 0; n < 2; ++n) bv[bj][n] = bias ? *(const f32x4*)(bias + bcol0 + bj * HALF + 4 * n) : (f32x4){0.f, 0.f, 0.f, 0.f};
#pragma unroll
        for (int ai = 0; ai < 2; ++ai)
#pragma unroll
            for (int m = 0; m < 4; ++m) { bf16_t* rowp = base + (size_t)(row0 + ai * HALF + m * 16) * ldc + col0;
#pragma unroll
                for (int bj = 0; bj < 2; ++bj) { f32x4 v0 = acc[ai][bj][m][0] + bv[bj][0], v1 = acc[ai][bj][m][1] + bv[bj][1];
                    if (ACT == 1) { f32x2 a = gelu_pk((f32x2){v0[0], v0[1]}), b = gelu_pk((f32x2){v0[2], v0[3]}), c = gelu_pk((f32x2){v1[0], v1[1]}), d = gelu_pk((f32x2){v1[2], v1[3]});
                        v0 = (f32x4){a.x, a.y, b.x, b.y}; v1 = (f32x4){c.x, c.y, d.x, d.y}; }
                    v0 = v0 * sc; v1 = v1 * sc; u32x4 w; w.x = cvt_pk_bf16(v0[0], v0[1]); w.y = cvt_pk_bf16(v0[2], v0[3]); w.z = cvt_pk_bf16(v1[0], v1[1]); w.w = cvt_pk_bf16(v1[2], v1[3]);
                    *(u32x4*)(rowp + bj * HALF) = w; } }
    }
};

template <class Epi, class Sched, bool ALIGN_EPI = false, bool SP2 = false>
__device__ __forceinline__ void gemm_phase(PG8_LAS unsigned char* lds, const Gemm g, const Sched& S, const Epi& E) {
    const int tid = opaque_tid(), wid = __builtin_amdgcn_readfirstlane(tid >> 6), lane = tid & 63, wr = wid >> 2, wc = wid & 3, fr = lane & 15, fq = lane >> 4;
    const int K = g.K, nt = K / BK;
    unsigned voffA[2], voffB[2];
#pragma unroll
    for (int i = 0; i < 2; ++i) { int R, C; stage_rc(tid * 16 + i * 8192, R, C); const int Rb = Epi::PERM ? ((R & ~31) + perm32(R & 31)) : R;
        voffA[i] = (unsigned)(R * K + C) * 2u; voffB[i] = (unsigned)(Rb * K + C) * 2u; }
    const size_t kstep = (size_t)(BK * 2);
    const size_t hstep = (size_t)HALF * K * 2;
    const size_t tstep = 2 * hstep;
    const unsigned ldsw = (unsigned)wid * 1024u;
    const int aoff = lds_byte(wr * 64 + fr, fq * 8), boff = lds_byte(wc * 32 + fr, fq * 8);
#define PG8_SA(b, h) (((b) * 2 + (h)) * HTB)
#define PG8_SB(b, h) ((4 + (b) * 2 + (h)) * HTB)
#define PG8_STAGE(bufoff, gbase, voff) do { _Pragma("unroll") for (int _i = 0; _i < 2; ++_i) \
        __builtin_amdgcn_global_load_lds((const unsigned*)((const char*)(gbase) + (voff)[_i]), (PG8_LAS unsigned*)(lds + (bufoff) + ldsw + _i * 8192), 16, 0, 0); } while (0)
#define PG8_LDA(dst, b, h) do { _Pragma("unroll") for (int m = 0; m < 4; ++m) _Pragma("unroll") for (int k = 0; k < 2; ++k) dst[m][k] = *(const PG8_LAS bf16x8*)(lds + PG8_SA(b, h) + aoff + m * 2048 + k * 1024); } while (0)
#define PG8_LDB(dst, b, h) do { _Pragma("unroll") for (int n = 0; n < 2; ++n) _Pragma("unroll") for (int k = 0; k < 2; ++k) dst[n][k] = *(const PG8_LAS bf16x8*)(lds + PG8_SB(b, h) + boff + n * 2048 + k * 1024); } while (0)
#define PG8_MMA(ai, bj, At, Bt) do { __builtin_amdgcn_s_setprio(1); _Pragma("unroll") for (int m = 0; m < 4; ++m) _Pragma("unroll") for (int n = 0; n < 2; ++n) _Pragma("unroll") for (int k = 0; k < 2; ++k) \
        acc[ai][bj][m][n] = __builtin_amdgcn_mfma_f32_16x16x32_bf16(Bt[n][k], At[m][k], acc[ai][bj][m][n], 0, 0, 0); __builtin_amdgcn_s_setprio(0); } while (0)
#define PG8_WAIT_V(n) asm volatile("s_waitcnt vmcnt(" #n ")" ::: "memory")
#define PG8_WAIT_L(n) asm volatile("s_waitcnt lgkmcnt(" #n ")" ::: "memory")
#define PG8_BAR __builtin_amdgcn_s_barrier()
#define PG8_SCHED __builtin_amdgcn_sched_barrier(0)
    Unit cur, nxt; int ui = 0;
    if (!S.next(0, cur)) return;
    f32x4 acc[2][2][4][2];
#pragma unroll
    for (int a = 0; a < 2; ++a)
#pragma unroll
        for (int b = 0; b < 2; ++b)
#pragma unroll
            for (int m = 0; m < 4; ++m)
#pragma unroll
                for (int n = 0; n < 2; ++n) acc[a][b][m][n] = (f32x4){0.f, 0.f, 0.f, 0.f};
    bf16x8 At[4][2], B0[2][2], B1[2][2];
    const char* cA = (const char*)g.A + (size_t)cur.pm * tstep; const char* cB = (const char*)g.Bt + (size_t)cur.pn * tstep;
    S.a_ready(cur);
    if constexpr (SP2) {
        PG8_STAGE(PG8_SB(0, 0), cB, voffB); PG8_STAGE(PG8_SB(0, 1), cB + hstep, voffB); PG8_STAGE(PG8_SA(0, 0), cA, voffA); PG8_STAGE(PG8_SA(0, 1), cA + hstep, voffA);
        if (wr == 1) PG8_BAR;
        PG8_WAIT_V(2); PG8_BAR;
        PG8_STAGE(PG8_SB(1, 0), cB + kstep, voffB); PG8_STAGE(PG8_SA(1, 0), cA + kstep, voffA); PG8_STAGE(PG8_SB(1, 1), cB + hstep + kstep, voffB);
        PG8_WAIT_V(6); PG8_BAR;
    } else {
        PG8_STAGE(PG8_SB(0, 0), cB, voffB); PG8_STAGE(PG8_SA(0, 0), cA, voffA); PG8_STAGE(PG8_SB(0, 1), cB + hstep, voffB); PG8_STAGE(PG8_SA(0, 1), cA + hstep, voffA);
        if (wr == 1) PG8_BAR;
        PG8_WAIT_V(4); PG8_BAR;
        PG8_STAGE(PG8_SB(1, 0), cB + kstep, voffB); PG8_STAGE(PG8_SA(1, 0), cA + kstep, voffA); PG8_STAGE(PG8_SB(1, 1), cB + hstep + kstep, voffB);
        PG8_WAIT_V(6); PG8_BAR;
    }
    for (;;) {
        const bool has_next = S.next(ui + 1, nxt);
        const char* nA = has_next ? (const char*)g.A + (size_t)nxt.pm * tstep : cA; const char* nB = has_next ? (const char*)g.Bt + (size_t)nxt.pn * tstep : cB;
        for (int t = 0; t < nt; t += 2) {
            const bool last = (t == nt - 2);
            const char* a1 = cA + (size_t)(t + 1) * kstep;
            const char* a2 = last ? nA : cA + (size_t)(t + 2) * kstep; const char* b2 = last ? nB : cB + (size_t)(t + 2) * kstep;
            const char* a3 = a2 + kstep; const char* b3 = b2 + kstep;
            if (last && has_next) S.a_ready(nxt);
            if constexpr (SP2) {
            PG8_LDB(B0, 0, 0); PG8_LDB(B1, 0, 1); PG8_SCHED; PG8_LDA(At, 0, 0); PG8_STAGE(PG8_SA(1, 1), a1 + hstep, voffA);
            PG8_WAIT_V(8); PG8_WAIT_L(0); PG8_BAR; PG8_MMA(0, 0, At, B0); PG8_MMA(0, 1, At, B1); PG8_BAR; PG8_SCHED;
            PG8_LDA(At, 0, 1); PG8_STAGE(PG8_SB(0, 0), b2, voffB); PG8_STAGE(PG8_SB(0, 1), b2 + hstep, voffB); PG8_STAGE(PG8_SA(0, 0), a2, voffA);
            PG8_WAIT_V(8); PG8_WAIT_L(0); PG8_BAR; PG8_MMA(1, 0, At, B0); PG8_MMA(1, 1, At, B1); PG8_BAR; PG8_SCHED;
            PG8_LDB(B0, 1, 0); PG8_LDB(B1, 1, 1); PG8_SCHED; PG8_LDA(At, 1, 0); PG8_STAGE(PG8_SA(0, 1), a2 + hstep, voffA);
            PG8_WAIT_V(8); PG8_WAIT_L(0); PG8_BAR; PG8_MMA(0, 0, At, B0); PG8_MMA(0, 1, At, B1); PG8_BAR; PG8_SCHED;
            PG8_LDA(At, 1, 1); PG8_STAGE(PG8_SB(1, 0), b3, voffB); PG8_STAGE(PG8_SB(1, 1), b3 + hstep, voffB); PG8_STAGE(PG8_SA(1, 0), a3, voffA);
            PG8_WAIT_V(8); PG8_WAIT_L(0); PG8_BAR; PG8_MMA(1, 0, At, B0); PG8_MMA(1, 1, At, B1); PG8_BAR; PG8_SCHED;
            } else {
            PG8_LDB(B0, 0, 0); PG8_SCHED; PG8_LDA(At, 0, 0); PG8_STAGE(PG8_SA(1, 1), a1 + hstep, voffA);
            PG8_WAIT_L(8); PG8_BAR; PG8_WAIT_L(0); PG8_MMA(0, 0, At, B0); PG8_BAR; PG8_SCHED;
            PG8_LDB(B1, 0, 1); PG8_STAGE(PG8_SB(0, 0), b2, voffB);
            PG8_BAR; PG8_WAIT_L(0); PG8_MMA(0, 1, At, B1); PG8_BAR;
            PG8_LDA(At, 0, 1); PG8_STAGE(PG8_SA(0, 0), a2, voffA);
            PG8_BAR; PG8_WAIT_L(0); PG8_MMA(1, 0, At, B0); PG8_BAR; PG8_SCHED;
            PG8_STAGE(PG8_SB(0, 1), b2 + hstep, voffB);
            PG8_WAIT_V(6); PG8_BAR; PG8_MMA(1, 1, At, B1); PG8_BAR;
            PG8_LDB(B0, 1, 0); PG8_SCHED; PG8_LDA(At, 1, 0); PG8_STAGE(PG8_SA(0, 1), a2 + hstep, voffA);
            PG8_WAIT_L(8); PG8_BAR; PG8_WAIT_L(0); PG8_MMA(0, 0, At, B0); PG8_BAR; PG8_SCHED;
            PG8_LDB(B1, 1, 1); PG8_STAGE(PG8_SB(1, 0), b3, voffB);
            PG8_BAR; PG8_WAIT_L(0); PG8_MMA(0, 1, At, B1); PG8_BAR;
            PG8_LDA(At, 1, 1); PG8_STAGE(PG8_SA(1, 0), a3, voffA);
            PG8_BAR; PG8_WAIT_L(0); PG8_MMA(1, 0, At, B0); PG8_BAR; PG8_SCHED;
            PG8_STAGE(PG8_SB(1, 1), b3 + hstep, voffB);
            PG8_WAIT_V(6); PG8_BAR; PG8_MMA(1, 1, At, B1); PG8_BAR;
            }
        }
        if constexpr (ALIGN_EPI) { if (wr == 0) PG8_BAR; }
        if constexpr (!Epi::AFTER_DRAIN) { E(acc, cur, wr, wc, fr, fq); S.done(cur); }
        if (!has_next) break;
#pragma unroll
        for (int a = 0; a < 2; ++a)
#pragma unroll
            for (int b = 0; b < 2; ++b)
#pragma unroll
                for (int m = 0; m < 4; ++m)
#pragma unroll
                    for (int n = 0; n < 2; ++n) acc[a][b][m][n] = (f32x4){0.f, 0.f, 0.f, 0.f};
        cur = nxt; cA = nA; cB = nB; ++ui;
        if constexpr (ALIGN_EPI) { if (wr == 1) PG8_BAR; }
    }
    PG8_WAIT_V(0);
    if constexpr (!ALIGN_EPI) { if (wr == 0) PG8_BAR; }
    PG8_BAR;
    if constexpr (Epi::AFTER_DRAIN) { E.fused(acc, cur, wr, wc, fr, fq, lds, wid, lane); S.done(cur); }
#undef PG8_SA
#undef PG8_SB
#undef PG8_STAGE
#undef PG8_LDA
#undef PG8_LDB
#undef PG8_MMA
#undef PG8_WAIT_V
#undef PG8_WAIT_L
#undef PG8_BAR
#undef PG8_SCHED
}
}

typedef unsigned short bf16;
typedef short bf16x8 __attribute__((ext_vector_type(8)));
typedef float f32x4 __attribute__((ext_vector_type(4)));
typedef unsigned u32x4 __attribute__((ext_vector_type(4)));
typedef unsigned u32x2 __attribute__((ext_vector_type(2)));

constexpr int SEQ = 16384, MTOK = 32768, DM = 1024, EVEN_IN = 3840, FF = 2816, QKVW = 1536;
constexpr int NTHR = 512;
constexpr size_t MiB = 1u << 20;
constexpr size_t E_WIN = 0, E_WOUT = E_WIN + 2ull * 3840 * 1024, E_WQKV = E_WOUT + 2ull * 1024 * 1024, E_WO = E_WQKV + 2ull * 1536 * 1024,
                 E_WGU = E_WO + 2ull * 1024 * 1024, E_WD = E_WGU + 4ull * 5632 * 1024, E_WL = E_WD + 4ull * 1024 * 2816, E_WEND = E_WL + 2ull * 1536 * 256;
static_assert(E_WEND * 2 <= 97 * MiB, "weights");
constexpr size_t WS_Z = 97 * MiB, WS_XN = 337 * MiB, WS_RB = 401 * MiB, WS_CTL = 465 * MiB, CTL_BYTES = 65536, WS_SSQ = 466 * MiB, WS_ROPE = 482 * MiB, WS_BON = 486 * MiB, WS_END = 487 * MiB;
constexpr int LDS_BYTES = 147456, MISC_OFF = 131072 + 64;
#define LAS __attribute__((address_space(3)))

__device__ __forceinline__ float bf2f(bf16 v) { return __uint_as_float(((unsigned)v) << 16); }
__device__ __forceinline__ unsigned pk2(float lo, float hi) { unsigned r; asm("v_cvt_pk_bf16_f32 %0, %1, %2" : "=v"(r) : "v"(lo), "v"(hi)); return r; }
__device__ __forceinline__ unsigned f2bf(float f) { return pk2(f, f) & 0xffffu; }
__device__ __forceinline__ float sigmoidf_(float x) { return __builtin_amdgcn_rcpf(1.f + __builtin_amdgcn_exp2f(x * -1.4426950408889634f)); }
__device__ __forceinline__ float wave_sum(float v) {
#pragma unroll
    for (int o = 1; o < 64; o <<= 1) v += __shfl_xor(v, o);
    return v;
}
template <int CTRL> __device__ __forceinline__ float dpp_mov(float v) { return __int_as_float(__builtin_amdgcn_update_dpp(0, __float_as_int(v), CTRL, 0xF, 0xF, true)); }
__device__ __forceinline__ float red8(float v) { v += dpp_mov<0xB1>(v); v += dpp_mov<0x4E>(v); v += dpp_mov<0x141>(v); return v; }
__device__ __forceinline__ float red16(float v) { v += dpp_mov<0xB1>(v); v += dpp_mov<0x4E>(v); v += dpp_mov<0x141>(v); v += dpp_mov<0x140>(v); return v; }
__device__ __forceinline__ float max16(float v) { v = fmaxf(v, dpp_mov<0xB1>(v)); v = fmaxf(v, dpp_mov<0x4E>(v)); v = fmaxf(v, dpp_mov<0x141>(v)); v = fmaxf(v, dpp_mov<0x140>(v)); return v; }

__device__ __forceinline__ f32x4 mma16(const bf16* A, int lda, int r0, const bf16* Bt, int ldb, int c0, int k0, f32x4 acc, int lane) {
    const int r = lane & 15, q = lane >> 4;
    const bf16x8 a = *(const bf16x8*)(A + (r0 + r) * lda + k0 + q * 8);
    const bf16x8 b = *(const bf16x8*)(Bt + (c0 + r) * ldb + k0 + q * 8);
    return __builtin_amdgcn_mfma_f32_16x16x32_bf16(a, b, acc, 0, 0, 0);
}

struct Params {
    const float *x, *norm1_g, *norm2_g, *final_g, *even_w_in, *even_w_out, *rwkv_mu, *rwkv_w0, *rwkv_w_up, *rwkv_a0, *rwkv_a_up, *rwkv_g_up,
                *rwkv_k_k, *rwkv_k_a, *rwkv_r_k, *rwkv_ln_g, *rwkv_ln_b, *swa_w_qkv, *swa_b_qkv, *swa_sinks, *swa_w_o, *swa_b_o, *ffn_w_gate, *ffn_w_up, *ffn_w_down;
    float* out; unsigned char* ws;
};

__device__ __forceinline__ float row_rstd(const float* ssq, int row) {
    const f32x4* q = (const f32x4*)(ssq + (size_t)row * 16); const f32x4 a = q[0], b = q[1], c = q[2], d = q[3];
    const float s = ((a[0] + a[1]) + (a[2] + a[3])) + ((b[0] + b[1]) + (b[2] + b[3])) + ((c[0] + c[1]) + (c[2] + c[3])) + ((d[0] + d[1]) + (d[2] + d[3]));
    return rsqrtf(s * (1.f / DM) + 1e-6f);
}
struct EpiStore {
    static constexpr bool PERM = true, AFTER_DRAIN = false;
    bf16* O; int ldc; const float* bias; const float* tab; mutable int k;
    __device__ __forceinline__ void operator()(const pg8::f32x4 (&acc)[2][2][4][2], const pg8::Unit& u, int wr, int wc, int fr, int fq) const {
        const int row0 = u.pm * 256 + wr * 64 + fr, col0 = u.pn * 256 + wc * 32 + 8 * fq;
        f32x4 bv[2][2];
#pragma unroll
        for (int bj = 0; bj < 2; ++bj)
#pragma unroll
            for (int n = 0; n < 2; ++n) bv[bj][n] = bias ? *(const f32x4*)(bias + col0 + bj * 128 + 4 * n) : (f32x4){0.f, 0.f, 0.f, 0.f};
#pragma unroll
        for (int ai = 0; ai < 2; ++ai)
#pragma unroll
            for (int m = 0; m < 4; ++m) { const int row = row0 + ai * 128 + m * 16; bf16* rowp = O + (size_t)row * ldc + col0;
                const float sc = tab[k * 256 + wr * 64 + fr + ai * 128 + m * 16];
#pragma unroll
                for (int bj = 0; bj < 2; ++bj) { const f32x4 v0 = acc[ai][bj][m][0] * sc + bv[bj][0], v1 = acc[ai][bj][m][1] * sc + bv[bj][1];
                    u32x4 w; w.x = pk2(v0[0], v0[1]); w.y = pk2(v0[2], v0[3]); w.z = pk2(v1[0], v1[1]); w.w = pk2(v1[2], v1[3]);
                    *(u32x4*)(rowp + bj * 128) = w; } }
        ++k;
    }
};
struct EpiRes {
    static constexpr bool PERM = true, AFTER_DRAIN = false;
    bf16* RB; int ldc; const float* bias; float* ssq;
    __device__ __forceinline__ void operator()(const pg8::f32x4 (&acc)[2][2][4][2], const pg8::Unit& u, int wr, int wc, int fr, int fq) const {
        const int col0 = u.pn * 256 + wc * 32 + 8 * fq;
        f32x4 bv[2][2];
#pragma unroll
        for (int bj = 0; bj < 2; ++bj)
#pragma unroll
            for (int n = 0; n < 2; ++n) bv[bj][n] = bias ? *(const f32x4*)(bias + col0 + bj * 128 + 4 * n) : (f32x4){0.f, 0.f, 0.f, 0.f};
#pragma unroll
        for (int ai = 0; ai < 2; ++ai)
#pragma unroll
            for (int m = 0; m < 4; ++m) { const int r = u.pm * 256 + ai * 128 + wr * 64 + m * 16 + fr; bf16* rowp = RB + (size_t)r * ldc + col0;
                float ss = 0.f;
#pragma unroll
                for (int bj = 0; bj < 2; ++bj) { const u32x4 old = *(const u32x4*)(rowp + bj * 128); u32x4 w;
#pragma unroll
                    for (int x = 0; x < 4; ++x) { const int n = x >> 1, e = (x & 1) * 2;
                        const float lo = __uint_as_float(old[x] << 16) + acc[ai][bj][m][n][e] + bv[bj][n][e], hi = __uint_as_float(old[x] & 0xffff0000u) + acc[ai][bj][m][n][e + 1] + bv[bj][n][e + 1];
                        const unsigned pw = pk2(lo, hi); w[x] = pw;
                        const float rl = __uint_as_float(pw << 16), rh = __uint_as_float(pw & 0xffff0000u); ss += rl * rl + rh * rh; }
                    *(u32x4*)(rowp + bj * 128) = w; }
                ss += __shfl_xor(ss, 16); ss += __shfl_xor(ss, 32);
                if (fq == 0) ssq[(size_t)r * 16 + u.pn * 4 + wc] = ss; }
    }
};
struct EpiSwiglu {
    static constexpr bool PERM = true, AFTER_DRAIN = false;
    bf16* O; int ldc; const float* tab; mutable int k;
    __device__ __forceinline__ void operator()(const pg8::f32x4 (&acc)[2][2][4][2], const pg8::Unit& u, int wr, int wc, int fr, int fq) const {
        const int row0 = u.pm * 256 + wr * 64 + fr, col0 = u.pn * 128 + wc * 32 + 8 * fq;
#pragma unroll
        for (int ai = 0; ai < 2; ++ai)
#pragma unroll
            for (int m = 0; m < 4; ++m) { const int row = row0 + ai * 128 + m * 16; bf16* rowp = O + (size_t)row * ldc + col0;
                const float sc = tab[k * 256 + wr * 64 + fr + ai * 128 + m * 16], sce = sc * -1.4426950408889634f, sc2 = sc * sc;
                float v[8];
#pragma unroll
                for (int n = 0; n < 2; ++n)
#pragma unroll
                    for (int x = 0; x < 4; ++x) { const float g = acc[ai][0][m][n][x], up = acc[ai][1][m][n][x];
                        v[4 * n + x] = (g * up) * (sc2 * __builtin_amdgcn_rcpf(1.f + __builtin_amdgcn_exp2f(g * sce))); }
                u32x4 w; w.x = pk2(v[0], v[1]); w.y = pk2(v[2], v[3]); w.z = pk2(v[4], v[5]); w.w = pk2(v[6], v[7]);
                *(u32x4*)rowp = w; }
        ++k;
    }
};
#ifndef GEMM_ALIGN
#define GEMM_ALIGN true
#endif
template <class Epi>
__device__ __forceinline__ void run_gemm(unsigned char* lds, const bf16* A, const bf16* Bt, int M, int N, int K, const Epi& E) {
    asm volatile("" : "+s"(N), "+s"(K));
    pg8::Gemm g{A, Bt, M, N, K}; pg8::StaticOrder S; S.init(M, N, (int)gridDim.x, (int)opaque_bid());
    pg8::gemm_phase<Epi, pg8::StaticOrder, GEMM_ALIGN, true>((PG8_LAS unsigned char*)lds, g, S, E);
}

constexpr int RSTD_OFF = 131072 + 256;
template <class Epi>
__device__ __forceinline__ void run_gemm_norm(unsigned char* lds, const bf16* A, const bf16* Bt, int M, int N, int K, const Epi& E, const float* ssq) {
    { asm volatile("" : "+s"(N));
      float* tab = (float*)(lds + RSTD_OFF); const int tid = opaque_tid();
      pg8::StaticOrder S; S.init(M, N, (int)gridDim.x, opaque_bid()); pg8::Unit u;
      for (int i = 0; i < 15 && S.next(i, u); ++i) if (tid < 256) tab[i * 256 + tid] = row_rstd(ssq, u.pm * 256 + tid);
      __syncthreads(); }
    run_gemm(lds, A, Bt, M, N, K, E);
}
__device__ __forceinline__ void tr_item(const float* W, int K, int N, bf16* WT, int mode, const float* gk, float* scr, int item, int lane) {
    const int nblk = N / 32, kb = item / nblk, nb = item % nblk, k0 = 64 * kb, n0 = 32 * nb;
    float wv[32];
#pragma unroll
    for (int i = 0; i < 32; ++i) wv[i] = W[(size_t)(k0 + 2 * i + (lane >> 5)) * N + n0 + (lane & 31)];
    const float g0 = gk ? gk[k0 + (lane >> 5) + 2 * (lane & 31)] : 1.f;
#pragma unroll
    for (int i = 0; i < 32; ++i) scr[(2 * i + (lane >> 5)) * 33 + (lane & 31)] = wv[i] * __shfl(g0, i + 32 * (lane >> 5));
    asm volatile("s_waitcnt lgkmcnt(0)" ::: "memory");
    const int c = lane & 7;
    const int d0 = mode == 0 ? n0 : ((n0 >> 7) * 256 + (n0 & 127) + (mode == 2 ? 128 : 0));
#pragma unroll
    for (int j = 0; j < 4; ++j) { const int n = (lane >> 3) + 8 * j; const float* s = scr + (8 * c) * 33 + n;
        u32x4 o; o.x = pk2(s[0 * 33], s[1 * 33]); o.y = pk2(s[2 * 33], s[3 * 33]); o.z = pk2(s[4 * 33], s[5 * 33]); o.w = pk2(s[6 * 33], s[7 * 33]);
        *(u32x4*)(WT + (size_t)(d0 + n) * K + k0 + 8 * c) = o; }
    asm volatile("s_waitcnt lgkmcnt(0)" ::: "memory");
}
__device__ __forceinline__ void tr_matrix(const float* W, int K, int N, bf16* WT, int mode, const float* gk, float* scr, int gw, int ngw, int lane) {
    const int nitems = (K / 64) * (N / 32);
    for (int it = gw; it < nitems; it += ngw) tr_item(W, K, N, WT, mode, gk, scr, it, lane);
}
typedef const Params __attribute__((address_space(4)))* ParamsPtr;
__device__ __forceinline__ void weights_phase(ParamsPtr pq, unsigned char* lds) {
#define p (*pq)
    const int tid = opaque_tid(), lane = tid & 63, wave = tid >> 6;
    float* scr = (float*)(lds + wave * 16384);
    const int gw = opaque_bid() * 8 + wave, ngw = gridDim.x * 8;
    bf16* wb = (bf16*)p.ws;
    for (int l = 0; l < 2; ++l) {
        tr_matrix(p.even_w_in + (size_t)l * 1024 * 3840, 1024, 3840, wb + E_WIN + (size_t)l * 3840 * 1024, 0, p.norm1_g + (2 * l) * DM, scr, gw, ngw, lane);
        tr_matrix(p.even_w_out + (size_t)l * 1024 * 1024, 1024, 1024, wb + E_WOUT + (size_t)l * 1024 * 1024, 0, nullptr, scr, gw, ngw, lane);
        tr_matrix(p.swa_w_qkv + (size_t)l * 1024 * 1536, 1024, 1536, wb + E_WQKV + (size_t)l * 1536 * 1024, 0, p.norm1_g + (2 * l + 1) * DM, scr, gw, ngw, lane);
        tr_matrix(p.swa_w_o + (size_t)l * 1024 * 1024, 1024, 1024, wb + E_WO + (size_t)l * 1024 * 1024, 0, nullptr, scr, gw, ngw, lane);
    }
    for (int l = 0; l < 4; ++l) {
        tr_matrix(p.ffn_w_gate + (size_t)l * 1024 * FF, 1024, FF, wb + E_WGU + (size_t)l * 5632 * 1024, 1, p.norm2_g + l * DM, scr, gw, ngw, lane);
        tr_matrix(p.ffn_w_up + (size_t)l * 1024 * FF, 1024, FF, wb + E_WGU + (size_t)l * 5632 * 1024, 2, p.norm2_g + l * DM, scr, gw, ngw, lane);
        tr_matrix(p.ffn_w_down + (size_t)l * FF * 1024, FF, 1024, wb + E_WD + (size_t)l * 1024 * FF, 0, nullptr, scr, gw, ngw, lane);
    }
    const int gt = opaque_bid() * NTHR + tid, ngt = gridDim.x * NTHR;
    for (int idx = gt; idx < 2 * 1536 * 256; idx += ngt) {
        const int l = idx / (1536 * 256), r = idx % (1536 * 256), n = r >> 8, k = r & 255; float v = 0.f;
        if (n < 512) { if (k < 64) v = p.rwkv_w_up[(size_t)l * 64 * 512 + k * 512 + n]; }
        else if (n < 1024) { if (k >= 64 && k < 128) v = p.rwkv_a_up[(size_t)l * 64 * 512 + (k - 64) * 512 + (n - 512)]; }
        else { if (k >= 128) v = p.rwkv_g_up[(size_t)l * 128 * 512 + (k - 128) * 512 + (n - 1024)]; }
        wb[E_WL + idx] = (bf16)f2bf(v);
    }
#undef p
}
__device__ __forceinline__ void init_rows_phase(const float* x, bf16* RB, float* ssq) {
    const int tid = opaque_tid(), lane = tid & 63, wave = tid >> 6;
    const int gw = opaque_bid() * 8 + wave, ngw = gridDim.x * 8;
    f32x4 nx[4];
    if (gw < MTOK) {
#pragma unroll
        for (int j = 0; j < 4; ++j) nx[j] = ((const f32x4*)(x + (size_t)gw * DM))[lane + 64 * j];
    }
    for (int m = gw; m < MTOK; m += ngw) {
        f32x4 cv[4];
#pragma unroll
        for (int j = 0; j < 4; ++j) cv[j] = nx[j];
        if (m + ngw < MTOK) {
#pragma unroll
            for (int j = 0; j < 4; ++j) nx[j] = ((const f32x4*)(x + (size_t)(m + ngw) * DM))[lane + 64 * j];
        }
        float s = 0.f;
#pragma unroll
        for (int j = 0; j < 4; ++j) { const f32x4 v = cv[j]; u32x2 w; w.x = pk2(v[0], v[1]); w.y = pk2(v[2], v[3]); ((u32x2*)(RB + (size_t)m * DM))[lane + 64 * j] = w;
            const float a0 = __uint_as_float(w.x << 16), a1 = __uint_as_float(w.x & 0xffff0000u), a2 = __uint_as_float(w.y << 16), a3 = __uint_as_float(w.y & 0xffff0000u);
            s += (a0 * a0 + a1 * a1) + (a2 * a2 + a3 * a3); }
        s = wave_sum(s);
        if (lane < 16) ssq[(size_t)m * 16 + lane] = lane == 0 ? s : 0.f;
    }
}
__device__ __forceinline__ void final_rms_phase(const bf16* RB, const float* g, float* outf) {
    const int tid = opaque_tid(), lane = tid & 63, wave = tid >> 6;
    const int gw = opaque_bid() * 8 + wave, ngw = gridDim.x * 8;
    f32x4 gv[4];
#pragma unroll
    for (int j = 0; j < 4; ++j) gv[j] = ((const f32x4*)g)[lane + 64 * j];
    u32x2 nw[4];
    if (gw < MTOK) {
#pragma unroll
        for (int j = 0; j < 4; ++j) nw[j] = ((const u32x2*)(RB + (size_t)gw * DM))[lane + 64 * j];
    }
    for (int m = gw; m < MTOK; m += ngw) {
        u32x2 cw[4];
#pragma unroll
        for (int j = 0; j < 4; ++j) cw[j] = nw[j];
        if (m + ngw < MTOK) {
#pragma unroll
            for (int j = 0; j < 4; ++j) nw[j] = ((const u32x2*)(RB + (size_t)(m + ngw) * DM))[lane + 64 * j];
        }
        f32x4 v[4]; float s = 0.f;
#pragma unroll
        for (int j = 0; j < 4; ++j) { const u32x2 w = cw[j];
            v[j] = (f32x4){__uint_as_float(w.x << 16), __uint_as_float(w.x & 0xffff0000u), __uint_as_float(w.y << 16), __uint_as_float(w.y & 0xffff0000u)};
            s += (v[j][0] * v[j][0] + v[j][1] * v[j][1]) + (v[j][2] * v[j][2] + v[j][3] * v[j][3]); }
        const float rstd = rsqrtf(wave_sum(s) * (1.f / DM) + 1e-6f);
#pragma unroll
        for (int j = 0; j < 4; ++j) ((f32x4*)(outf + (size_t)m * DM))[lane + 64 * j] = v[j] * rstd * gv[j];
    }
}
__device__ __forceinline__ float rope_inv_freq(int p) { return exp2f(-(float)p * (13.287712379549449f / 31.0f)); }
typedef short s16x4 __attribute__((ext_vector_type(4)));
typedef float f32x2v __attribute__((ext_vector_type(2)));
__device__ __forceinline__ bf16x8 tr_frag(const bf16* X, int ld, int k0, int c0, int lane) {
    const int g = lane >> 4, i = lane & 15, q = i >> 2, pp = i & 3;
    const bf16* a0 = X + (k0 + g * 8 + q) * ld + c0 + 4 * pp;
    const s16x4 lo = __builtin_amdgcn_ds_read_tr16_b64_v4i16((LAS s16x4*)a0);
    const s16x4 hi = __builtin_amdgcn_ds_read_tr16_b64_v4i16((LAS s16x4*)(a0 + 4 * ld));
    return (bf16x8){lo[0], lo[1], lo[2], lo[3], hi[0], hi[1], hi[2], hi[3]};
}
__device__ __forceinline__ f32x4 mma16_tb(const bf16* A, int lda, int r0, const bf16* B, int ldb, int c0, int k0, f32x4 acc, int lane) {
    const bf16x8 a = *(const bf16x8*)(A + (r0 + (lane & 15)) * lda + k0 + (lane >> 4) * 8);
    return __builtin_amdgcn_mfma_f32_16x16x32_bf16(a, tr_frag(B, ldb, k0, c0, lane), acc, 0, 0, 0);
}
__device__ __forceinline__ void rope_table_phase(f32x2v* tab) {
    const int gt = opaque_bid() * NTHR + opaque_tid(), ngt = gridDim.x * NTHR;
    for (int idx = gt; idx < SEQ * 32; idx += ngt) { const float ang = (float)(idx >> 5) * rope_inv_freq(idx & 31); tab[idx] = (f32x2v){cosf(ang), sinf(ang)}; }
}
__device__ __forceinline__ void ret_kv_phase(bf16* Z, float* KV, const f32x2v* rope, unsigned char* lds) {
    bf16* Ks = (bf16*)lds; bf16* Vs = (bf16*)(lds + 18432);
    const int tid = opaque_tid(), lane = tid & 63, wave = tid >> 6, r16 = lane & 15, q4 = lane >> 4;
    u32x2 fql_[2], fqh_[2], fkl_[2], fkh_[2]; f32x4 fc0_[2], fc1_[2]; u32x4 fv_[2];
#define RK_FETCH(u_) do { const int b_ = (u_) >> 10, h_ = ((u_) >> 7) & 7, n_ = (u_) & 127; const size_t rb_ = (size_t)b_ * SEQ + n_ * 128; \
        _Pragma("unroll") for (int it = 0; it < 2; ++it) { const int idx = tid + it * NTHR, p4 = (idx & 7) * 4, i = idx >> 3; \
            const bf16* zq = Z + (rb_ + i) * EVEN_IN + h_ * 64 + p4; const f32x4* rp_ = (const f32x4*)(rope + (n_ * 128 + i) * 32 + p4); \
            fql_[it] = *(const u32x2*)zq; fqh_[it] = *(const u32x2*)(zq + 32); fkl_[it] = *(const u32x2*)(zq + 512); fkh_[it] = *(const u32x2*)(zq + 544); fc0_[it] = rp_[0]; fc1_[it] = rp_[1]; \
            fv_[it] = *(const u32x4*)(Z + (rb_ + (idx >> 3)) * EVEN_IN + 1024 + h_ * 64 + (idx & 7) * 8); } } while (0)
    { const int u0 = opaque_bid(); if (u0 < 2048) RK_FETCH(u0); }
    for (int u = opaque_bid(); u < 2048; u += gridDim.x) {
        const int b = u >> 10, h = (u >> 7) & 7, n = u & 127; const size_t rowbase = (size_t)b * SEQ + n * 128;
        const float lg = log1pf(-exp2f(-5.f - (float)h));
        __syncthreads();
#pragma unroll
        for (int it = 0; it < 2; ++it) { const int idx = tid + it * NTHR, p4 = (idx & 7) * 4, i = idx >> 3;
            bf16* zq = Z + (rowbase + i) * EVEN_IN + h * 64 + p4; bf16* zk = zq + 512;
            const f32x4 c01 = fc0_[it], c23 = fc1_[it];
            const float cs_[4] = {c01[0], c01[2], c23[0], c23[2]}, sn_[4] = {c01[1], c01[3], c23[1], c23[3]};
            const u32x2 ql = fql_[it], qh = fqh_[it], kl = fkl_[it], kh = fkh_[it];
            const float kd = __expf((float)(127 - i) * lg);
            float q1[4], q2[4], k1[4], k2[4];
#pragma unroll
            for (int x = 0; x < 4; ++x) { const int sh = 16 * (x & 1), wi = x >> 1;
                const float a1 = bf2f((bf16)(ql[wi] >> sh)), a2 = bf2f((bf16)(qh[wi] >> sh)), b1 = bf2f((bf16)(kl[wi] >> sh)), b2 = bf2f((bf16)(kh[wi] >> sh));
                q1[x] = a1 * cs_[x] - a2 * sn_[x]; q2[x] = a1 * sn_[x] + a2 * cs_[x];
                k1[x] = (b1 * cs_[x] - b2 * sn_[x]) * 0.125f; k2[x] = (b1 * sn_[x] + b2 * cs_[x]) * 0.125f; }
            *(u32x2*)zq = (u32x2){pk2(q1[0], q1[1]), pk2(q1[2], q1[3])}; *(u32x2*)(zq + 32) = (u32x2){pk2(q2[0], q2[1]), pk2(q2[2], q2[3])};
            *(u32x2*)zk = (u32x2){pk2(k1[0], k1[1]), pk2(k1[2], k1[3])}; *(u32x2*)(zk + 32) = (u32x2){pk2(k2[0], k2[1]), pk2(k2[2], k2[3])};
            *(u32x2*)(Ks + i * 72 + p4) = (u32x2){pk2(k1[0] * kd, k1[1] * kd), pk2(k1[2] * kd, k1[3] * kd)};
            *(u32x2*)(Ks + i * 72 + 32 + p4) = (u32x2){pk2(k2[0] * kd, k2[1] * kd), pk2(k2[2] * kd, k2[3] * kd)};
            *(u32x4*)(Vs + (idx >> 3) * 72 + (idx & 7) * 8) = fv_[it]; }
        __syncthreads();
        { const int un = u + (int)gridDim.x; if (un < 2048) RK_FETCH(un); }
        const int dtile = wave >> 1;
#pragma unroll
        for (int e2 = 0; e2 < 2; ++e2) { const int etile = (wave & 1) * 2 + e2; f32x4 acc = {0.f, 0.f, 0.f, 0.f};
#pragma unroll
            for (int k0 = 0; k0 < 128; k0 += 32) acc = __builtin_amdgcn_mfma_f32_16x16x32_bf16(tr_frag(Ks, 72, k0, 16 * dtile, lane), tr_frag(Vs, 72, k0, 16 * etile, lane), acc, 0, 0, 0);
#pragma unroll
            for (int jj = 0; jj < 4; ++jj) KV[((size_t)u * 64 + 16 * dtile + q4 * 4 + jj) * 64 + 16 * etile + r16] = acc[jj]; }
    }
}
template <bool STORE>
__device__ __forceinline__ void ret_scan_phase(const float* KV, bf16* SP) {
    const int gt = opaque_bid() * NTHR + opaque_tid(), ngt = gridDim.x * NTHR;
    for (int e = gt; e < 65536; e += ngt) {
        const int bh = e >> 12, de = e & 4095, h = bh & 7;
        const float cd = expf(128.f * log1pf(-exp2f(-5.f - (float)h)));
        float st = 0.f; const float* ptr = KV + (size_t)bh * 128 * 4096 + de; bf16* sp = SP + (size_t)bh * 128 * 4096 + de;
        float nk[16];
#pragma unroll
        for (int x = 0; x < 16; ++x) nk[x] = ptr[(size_t)x * 4096];
        for (int n0 = 0; n0 < 128; n0 += 16) { float kv[16];
#pragma unroll
            for (int x = 0; x < 16; ++x) kv[x] = nk[x];
            if (n0 + 16 < 128) {
#pragma unroll
                for (int x = 0; x < 16; ++x) nk[x] = ptr[(size_t)(n0 + 16 + x) * 4096];
            }
#pragma unroll
            for (int x = 0; x < 16; ++x) { if (STORE) sp[(size_t)(n0 + x) * 4096] = (bf16)f2bf(st); st = cd * st + kv[x]; } }
        if (!STORE && st == 1.2345e-30f) sp[0] = (bf16)f2bf(st);
    }
}
__device__ __forceinline__ void ret_out_phase(const bf16* Z, const bf16* SP, bf16* MIX, unsigned char* lds) {
    bf16* Qs = (bf16*)lds; bf16* Ks = (bf16*)(lds + 18432); bf16* Vs = (bf16*)(lds + 36864); bf16* Ss = (bf16*)(lds + 55296); bf16* Ps = (bf16*)(lds + 64512);
    const int tid = opaque_tid(), lane = tid & 63, wave = tid >> 6, r16 = lane & 15, q4 = lane >> 4;
    u32x4 fk_[2], fv_[2]; u32x2 fs_[2];
#define RO_FETCH(u_) do { const int b_ = (u_) >> 10, h_ = ((u_) >> 7) & 7, n_ = (u_) & 127; const size_t rb_ = (size_t)b_ * SEQ + n_ * 128; \
        _Pragma("unroll") for (int it = 0; it < 2; ++it) { const int ci = tid + it * NTHR, j = ci >> 3, c8 = (ci & 7) * 8; const bf16* src = Z + (rb_ + j) * EVEN_IN + h_ * 64 + c8; \
            fk_[it] = *(const u32x4*)(src + 512); fv_[it] = *(const u32x4*)(src + 1024); \
            fs_[it] = *(const u32x2*)(SP + (size_t)(u_) * 4096 + (ci >> 4) * 64 + (ci & 15) * 4); } } while (0)
    { const int u0 = opaque_bid(); if (u0 < 2048) RO_FETCH(u0); }
    for (int u = opaque_bid(); u < 2048; u += gridDim.x) {
        const int b = u >> 10, h = (u >> 7) & 7, n = u & 127; const size_t rowbase = (size_t)b * SEQ + n * 128;
        const float lg = log1pf(-exp2f(-5.f - (float)h));
        __syncthreads();
#pragma unroll
        for (int it = 0; it < 2; ++it) { const int ci = tid + it * NTHR, j = ci >> 3, c8 = (ci & 7) * 8;
            *(u32x4*)(Ks + j * 72 + c8) = fk_[it]; *(u32x4*)(Vs + j * 72 + c8) = fv_[it];
            *(u32x2*)(Ss + (ci >> 4) * 72 + (ci & 15) * 4) = fs_[it]; }
        bf16x8 qf[2];
#pragma unroll
        for (int ks = 0; ks < 2; ++ks) qf[ks] = *(const bf16x8*)(Z + (rowbase + 16 * wave + r16) * EVEN_IN + h * 64 + 32 * ks + q4 * 8);
        __syncthreads();
        { const int un = u + (int)gridDim.x; if (un < 2048) RO_FETCH(un); }
        f32x4 acc[8];
#pragma unroll
        for (int kt = 0; kt < 8; ++kt) { acc[kt] = (f32x4){0.f, 0.f, 0.f, 0.f};
            if (kt <= wave) {
#pragma unroll
                for (int ks = 0; ks < 2; ++ks) acc[kt] = __builtin_amdgcn_mfma_f32_16x16x32_bf16(qf[ks], *(const bf16x8*)(Ks + (16 * kt + r16) * 72 + 32 * ks + q4 * 8), acc[kt], 0, 0, 0); } }
#pragma unroll
        for (int kt = 0; kt < 8; ++kt)
#pragma unroll
            for (int jj = 0; jj < 4; ++jj) { const int i = 16 * wave + q4 * 4 + jj, j = 16 * kt + r16;
                const float val = (i >= j) ? acc[kt][jj] * __expf((float)(i - j) * lg) : 0.f;
                Ps[i * 136 + j] = (bf16)f2bf(val); }
        asm volatile("s_waitcnt lgkmcnt(0)" ::: "memory");
        f32x4 o[4], o2[4];
#pragma unroll
        for (int dt = 0; dt < 4; ++dt) { o[dt] = (f32x4){0.f, 0.f, 0.f, 0.f}; o2[dt] = (f32x4){0.f, 0.f, 0.f, 0.f};
#pragma unroll
            for (int k0 = 0; k0 < 128; k0 += 32) if (k0 <= 16 * wave) o[dt] = mma16_tb(Ps, 136, 16 * wave, Vs, 72, 16 * dt, k0, o[dt], lane);
#pragma unroll
            for (int ks = 0; ks < 2; ++ks) o2[dt] = __builtin_amdgcn_mfma_f32_16x16x32_bf16(qf[ks], tr_frag(Ss, 72, 32 * ks, 16 * dt, lane), o2[dt], 0, 0, 0); }
#pragma unroll
        for (int jj = 0; jj < 4; ++jj) { const int i = 16 * wave + q4 * 4 + jj; const float qd = __expf((float)(i + 1) * lg);
            float v[4]; float s = 0.f;
#pragma unroll
            for (int dt = 0; dt < 4; ++dt) { v[dt] = o[dt][jj] + qd * o2[dt][jj]; s += v[dt]; }
            const float mean = red16(s) * (1.f / 64.f); float q = 0.f;
#pragma unroll
            for (int dt = 0; dt < 4; ++dt) { v[dt] -= mean; q += v[dt] * v[dt]; }
            const float rstd = rsqrtf(red16(q) * (1.f / 64.f) + 1e-6f);
#pragma unroll
            for (int dt = 0; dt < 4; ++dt) Ps[i * 136 + 16 * dt + r16] = (bf16)f2bf(v[dt] * rstd); }
#pragma unroll
        for (int t2 = 0; t2 < 2; ++t2) { const int cidx = lane + 64 * t2, i = 16 * wave + (cidx >> 3), c8 = (cidx & 7) * 8;
            const u32x4 ov = *(const u32x4*)(Ps + i * 136 + c8), gv = *(const u32x4*)(Z + (rowbase + i) * EVEN_IN + 1536 + h * 64 + c8); u32x4 w;
#pragma unroll
            for (int x = 0; x < 4; ++x) { const float g0 = __uint_as_float(gv[x] << 16), g1 = __uint_as_float(gv[x] & 0xffff0000u);
                w[x] = pk2(__uint_as_float(ov[x] << 16) * g0 * sigmoidf_(g0), __uint_as_float(ov[x] & 0xffff0000u) * g1 * sigmoidf_(g1)); }
            *(u32x4*)(MIX + (rowbase + i) * DM + h * 64 + c8) = w; }
    }
}

__device__ __forceinline__ void swa_phase(const bf16* QKV, bf16* MIX, const float* sinks, unsigned char* lds) {
    bf16* Ks = (bf16*)lds; bf16* Vs = (bf16*)(lds + 36864); bf16* Qs = (bf16*)(lds + 73728); bf16* Ps = (bf16*)(lds + 92160);
    const int tid = opaque_tid(), lane = tid & 63, wave = tid >> 6, r16 = lane & 15, q4 = lane >> 4;
    u32x4 pk_[4], pv_[4];
#define SWA_FETCH(u_) do { const int b_ = (u_) >> 9, kvh_ = ((u_) >> 7) & 3, n_ = (u_) & 127; const size_t rb_ = (size_t)b_ * SEQ + n_ * 128; \
        _Pragma("unroll") for (int it = 0; it < 4; ++it) { const int ci = tid + it * NTHR, kj = ci >> 3, c8 = (ci & 7) * 8; pk_[it] = (u32x4){0u, 0u, 0u, 0u}; pv_[it] = (u32x4){0u, 0u, 0u, 0u}; \
            if (n_ > 0 || kj >= 128) { const bf16* src = QKV + (rb_ - 128 + kj) * QKVW + kvh_ * 64 + c8; pk_[it] = *(const u32x4*)(src + 1024); pv_[it] = *(const u32x4*)(src + 1280); } } } while (0)
    { const int u0 = opaque_bid(); if (u0 < 1024) SWA_FETCH(u0); }
    for (int u = opaque_bid(); u < 1024; u += gridDim.x) {
        const int b = u >> 9, kvh = (u >> 7) & 3, n = u & 127; const size_t rowbase = (size_t)b * SEQ + n * 128;
        __syncthreads();
#pragma unroll
        for (int it = 0; it < 4; ++it) { const int ci = tid + it * NTHR, kj = ci >> 3, c8 = (ci & 7) * 8; *(u32x4*)(Ks + kj * 72 + c8) = pk_[it]; *(u32x4*)(Vs + kj * 72 + c8) = pv_[it]; }
        __syncthreads();
        { const int un = u + (int)gridDim.x; if (un < 1024) SWA_FETCH(un); }
        for (int g = 0; g < 4; ++g) {
            const int hq = kvh * 4 + g;
            bf16x8 qf[2];
#pragma unroll
            for (int ks = 0; ks < 2; ++ks) qf[ks] = *(const bf16x8*)(QKV + (rowbase + 16 * wave + r16) * QKVW + hq * 64 + 32 * ks + q4 * 8);
            f32x4 acc[16];
            const float sink = sinks[hq];
            float mx[4] = {-INFINITY, -INFINITY, -INFINITY, -INFINITY};
#pragma unroll
            for (int kt = 0; kt < 16; ++kt) {
                if (kt >= wave && kt <= wave + 8) {
                    acc[kt] = (f32x4){0.f, 0.f, 0.f, 0.f};
#pragma unroll
                    for (int ks = 0; ks < 2; ++ks) acc[kt] = __builtin_amdgcn_mfma_f32_16x16x32_bf16(qf[ks], *(const bf16x8*)(Ks + (16 * kt + r16) * 72 + 32 * ks + q4 * 8), acc[kt], 0, 0, 0);
#pragma unroll
                    for (int jj = 0; jj < 4; ++jj) { const int qi = 16 * wave + q4 * 4 + jj, kj = 16 * kt + r16, rel = qi + 128 - kj;
                        const bool valid = (rel >= 0) && (rel < 128) && ((n > 0) || (kj >= 128));
                        const float sv = valid ? acc[kt][jj] * 0.125f : -INFINITY; acc[kt][jj] = sv; mx[jj] = fmaxf(mx[jj], sv); }
                } else acc[kt] = (f32x4){-INFINITY, -INFINITY, -INFINITY, -INFINITY};
            }
            float sum[4];
#pragma unroll
            for (int jj = 0; jj < 4; ++jj) { mx[jj] = fmaxf(max16(mx[jj]), sink); sum[jj] = 0.f; }
#pragma unroll
            for (int kt = 0; kt < 16; ++kt) {
                if (kt >= wave && kt <= wave + 8) {
#pragma unroll
                    for (int jj = 0; jj < 4; ++jj) { const float e = __expf(acc[kt][jj] - mx[jj]); acc[kt][jj] = e; sum[jj] += e; }
                } else acc[kt] = (f32x4){0.f, 0.f, 0.f, 0.f};
            }
#pragma unroll
            for (int jj = 0; jj < 4; ++jj) sum[jj] = red16(sum[jj]) + __expf(sink - mx[jj]);
            f32x4 o[4];
#pragma unroll
            for (int dt = 0; dt < 4; ++dt) o[dt] = (f32x4){0.f, 0.f, 0.f, 0.f};
#pragma unroll
            for (int half = 0; half < 2; ++half) {
#pragma unroll
                for (int k8 = 0; k8 < 8; ++k8)
#pragma unroll
                    for (int jj = 0; jj < 4; ++jj) Ps[(16 * wave + q4 * 4 + jj) * 136 + k8 * 16 + r16] = (bf16)f2bf(acc[half * 8 + k8][jj]);
                asm volatile("s_waitcnt lgkmcnt(0)" ::: "memory");
#pragma unroll
                for (int k0 = 0; k0 < 128; k0 += 32) { const int kt0 = half * 8 + (k0 >> 4);
                    if (kt0 + 1 >= wave && kt0 <= wave + 8) {
#pragma unroll
                        for (int dt = 0; dt < 4; ++dt) o[dt] = mma16_tb(Ps, 136, 16 * wave, Vs + half * 128 * 72, 72, 16 * dt, k0, o[dt], lane); } }
            }
#pragma unroll
            for (int jj = 0; jj < 4; ++jj) { const float inv = __builtin_amdgcn_rcpf(sum[jj]); const int i = 16 * wave + q4 * 4 + jj;
#pragma unroll
                for (int dt = 0; dt < 4; ++dt) Ps[i * 136 + 16 * dt + r16] = (bf16)f2bf(o[dt][jj] * inv); }
#pragma unroll
            for (int t2 = 0; t2 < 2; ++t2) { const int cidx = lane + 64 * t2, i = 16 * wave + (cidx >> 3), c8 = (cidx & 7) * 8;
                *(u32x4*)(MIX + (rowbase + i) * DM + hq * 64 + c8) = *(const u32x4*)(Ps + i * 136 + c8); }
        }
    }
}

struct RwkvW { const float *mu, *k_k, *k_a, *r_k, *ln_g, *ln_b, *w0, *a0; };
__device__ __forceinline__ float fma_s(float a, float b, float c) { float d; asm("v_fma_f32 %0, %1, %2, %3" : "=v"(d) : "v"(a), "v"(b), "v"(c)); return d; }
__device__ __forceinline__ float mul_s(float a, float b) { float d; asm("v_mul_f32 %0, %1, %2" : "=v"(d) : "v"(a), "v"(b)); return d; }
#ifndef SLOG
#define SLOG 3
#endif
constexpr int SCH = 128 << SLOG, NCHK = SEQ / SCH;
struct ScanRaw { u32x2 cr, ck, cv, pr, pk, pv, cwl, pwl, cal, pal; u32x4 cgl, pgl; };
typedef _Float16 h2 __attribute__((ext_vector_type(2)));
__device__ __forceinline__ h2 u2h(unsigned u) { return __builtin_bit_cast(h2, u); }
__device__ __forceinline__ unsigned pkh(float lo, float hi) { const h2 v = {(_Float16)lo, (_Float16)hi}; return __builtin_bit_cast(unsigned, v); }
__device__ __forceinline__ float hsum(h2 v) { return (float)v[0] + (float)v[1]; }
#define SCAN_STEPS(HASP)             { \
                const unsigned char* q = buf + j0 * 2; const unsigned char* qv = buf + O_V2 + rp * 4; \
                u32x4 na8 = *(const u32x4*)q, nb8 = *(const u32x4*)(q + O_B), nw8 = *(const u32x4*)(q + O_W), nk8 = *(const u32x4*)(q + O_K), nr8 = *(const u32x4*)(q + O_R); \
                unsigned nv = *(const unsigned*)qv; \
_Pragma("unroll 4") \
                for (int tt = 0; tt < 32; ++tt) { \
                    const u32x4 a8 = na8, b8 = nb8, w8 = nw8, k8 = nk8, r8 = nr8; const h2 vi2 = u2h(nv); \
                    { const int tn = (tt + 1) & 31;    \
                      na8 = *(const u32x4*)(q + tn * 128); nb8 = *(const u32x4*)(q + O_B + tn * 128); nw8 = *(const u32x4*)(q + O_W + tn * 128); nk8 = *(const u32x4*)(q + O_K + tn * 128); \
                      nr8 = *(const u32x4*)(q + O_R + tn * 128); \
                      nv = *(const unsigned*)(qv + tn * 256); } \
                    __builtin_amdgcn_sched_barrier(0); \
                    h2 du = SU[0] * u2h(a8[0]); \
_Pragma("unroll") \
                    for (int x = 1; x < 4; ++x) du = SU[x] * u2h(a8[x]) + du; \
                    const float sau = red8(hsum(du)); \
                    const h2 sau2 = {(_Float16)sau, (_Float16)sau}; \
                    if (PASS == 1 && HASP) { \
                        h2 dp = SP[0] * u2h(a8[0]); \
_Pragma("unroll") \
                        for (int x = 1; x < 4; ++x) dp = SP[x] * u2h(a8[x]) + dp; \
                        const float sap = red8(hsum(dp)); \
                        const h2 sap2 = {(_Float16)sap, (_Float16)sap}; \
_Pragma("unroll") \
                        for (int x = 0; x < 4; ++x) SP[x] = SP[x] * u2h(w8[x]) + sap2 * u2h(b8[x]); \
                    } \
_Pragma("unroll") \
                    for (int x = 0; x < 4; ++x) SU[x] = SU[x] * u2h(w8[x]) + (sau2 * u2h(b8[x]) + vi2 * u2h(k8[x])); \
                    if (PASS == 1) {    \
                        h2 dy = SU[0] * u2h(r8[0]), dq = SP[0] * u2h(r8[0]); \
_Pragma("unroll") \
                        for (int x = 1; x < 4; ++x) { dy = SU[x] * u2h(r8[x]) + dy; if (HASP) dq = SP[x] * u2h(r8[x]) + dq; } \
                        const float y = red8(hsum(dy)), rho = HASP ? red8(hsum(dq)) : 0.f; \
                        if (sl == 0) { *(float*)(buf + O_Y + (tt * 64 + rp) * 4) = y; *(float*)(buf + O_VF + (tt * 64 + rp) * 4) = rho; } \
                    } \
                    if (PASS == 3) { \
                        h2 dy = SU[0] * u2h(r8[0]); \
_Pragma("unroll") \
                        for (int x = 1; x < 4; ++x) dy = SU[x] * u2h(r8[x]) + dy; \
                        const float y = red8(hsum(dy)); \
                        if (sl == 0) *(float*)(buf + O_Y + (tt * 64 + rp) * 4) = y; \
                    } \
                } \
            }
template <int PASS>
__device__ __forceinline__ void rwkv_scan_phase(const bf16* Z, const RwkvW w, const bf16* Wl, float* Pb, float* Ub, bf16* MIX, bf16* RHO, float* BON, unsigned char* lds) {
    constexpr int SBUF = 45312, O_B = 4096, O_W = 8192, O_K = 12288, O_R = 16384, O_V2 = 20480, O_VF = 28672, O_Y = 36864, O_BON = 45056;
    constexpr int O_AW = 2 * SBUF, O_AA = O_AW + 4608, O_AG = O_AA + 4608, O_PU = O_AG + 8704, O_PA = O_PU + 8192, O_PG = O_PA + 8192;
    static_assert(O_PG + 4096 <= 131072, "scan LDS");
    const int tid = opaque_tid();
    const int rp = tid >> 3, sl = tid & 7, j0 = sl * 8;
    const int ptt = tid >> 4, pjg = (tid & 15) * 4;
    const int lane = tid & 63, wave = tid >> 6, r16 = lane & 15, q4 = lane >> 4, mrt = wave >> 2, mdt = wave & 3;
    for (int u = opaque_bid(); u < 16 * NCHK; u += gridDim.x) {
        const int bh = u / NCHK, c = u % NCHK, b = bh >> 3, h = bh & 7, col = h * 64 + pjg;
        const f32x4 mu_r = *(const f32x4*)(w.mu + col), mu_k = *(const f32x4*)(w.mu + 512 + col), mu_v = *(const f32x4*)(w.mu + 1024 + col);
        const f32x4 kkc = *(const f32x4*)(w.k_k + col), kac = *(const f32x4*)(w.k_a + col), w0c = *(const f32x4*)(w.w0 + col), a0c = *(const f32x4*)(w.a0 + col), rkc = *(const f32x4*)(w.r_k + col);
        f32x4 lgc = {0.f, 0.f, 0.f, 0.f}, lbc = {0.f, 0.f, 0.f, 0.f};
        if (PASS == 3) { lgc = *(const f32x4*)(w.ln_g + col); lbc = *(const f32x4*)(w.ln_b + col); }
        const f32x4 mu_wl = *(const f32x4*)(w.mu + 1536 + pjg), mu_al = *(const f32x4*)(w.mu + 1600 + pjg);
        f32x4 mu_g0 = {0.f, 0.f, 0.f, 0.f}, mu_g1 = {0.f, 0.f, 0.f, 0.f};
        if (PASS == 3) { mu_g0 = *(const f32x4*)(w.mu + 1664 + 2 * pjg); mu_g1 = *(const f32x4*)(w.mu + 1668 + 2 * pjg); }
        bf16x8 bw[2], ba[2], bg[4];
        { const bf16* wr_ = Wl + (size_t)(h * 64 + 16 * mdt + r16) * 256 + q4 * 8;
#pragma unroll
          for (int ks = 0; ks < 2; ++ks) { bw[ks] = *(const bf16x8*)(wr_ + 32 * ks); ba[ks] = *(const bf16x8*)(wr_ + 512 * 256 + 64 + 32 * ks); }
#pragma unroll
          for (int ks = 0; ks < 4; ++ks) bg[ks] = (PASS == 3) ? *(const bf16x8*)(wr_ + 1024 * 256 + 128 + 32 * ks) : bw[0]; }
        h2 SU[4], SP[4];
        if (PASS == 1) {
#pragma unroll
            for (int x = 0; x < 4; ++x) { SU[x] = (h2){(_Float16)0.f, (_Float16)0.f}; SP[x] = (h2){(_Float16)((rp == j0 + 2 * x) ? 1.f : 0.f), (_Float16)((rp == j0 + 2 * x + 1) ? 1.f : 0.f)}; }
        } else {
            if (c == 0) {
#pragma unroll
                for (int x = 0; x < 4; ++x) SU[x] = (h2){(_Float16)0.f, (_Float16)0.f};
            } else { const float* sp = Ub + ((size_t)(u - 1) * 64 + rp) * 64 + j0; const f32x4 t0 = *(const f32x4*)sp, t1 = *(const f32x4*)(sp + 4);
                SU[0] = (h2){(_Float16)t0[0], (_Float16)t0[1]}; SU[1] = (h2){(_Float16)t0[2], (_Float16)t0[3]}; SU[2] = (h2){(_Float16)t1[0], (_Float16)t1[1]}; SU[3] = (h2){(_Float16)t1[2], (_Float16)t1[3]}; }
#pragma unroll
            for (int x = 0; x < 4; ++x) SP[x] = (h2){(_Float16)0.f, (_Float16)0.f};
        }
        ScanRaw raw;
#define SCAN_LOAD_RAW(sub_) do { const int t_ = c * SCH + (sub_) * 32 + ptt; const bf16* zc = Z + ((size_t)b * SEQ + t_) * EVEN_IN; const bf16* zp = zc - EVEN_IN; \
            raw.cr = *(const u32x2*)(zc + 2048 + col); raw.ck = *(const u32x2*)(zc + 2560 + col); raw.cv = *(const u32x2*)(zc + 3072 + col); \
            raw.cwl = *(const u32x2*)(zc + 3584 + pjg); raw.cal = *(const u32x2*)(zc + 3648 + pjg); if (PASS == 3) raw.cgl = *(const u32x4*)(zc + 3712 + 2 * pjg); \
            raw.pr = (u32x2){0u, 0u}; raw.pk = (u32x2){0u, 0u}; raw.pv = (u32x2){0u, 0u}; raw.pwl = (u32x2){0u, 0u}; raw.pal = (u32x2){0u, 0u}; raw.pgl = (u32x4){0u, 0u, 0u, 0u}; \
            if (t_ > 0) { raw.pr = *(const u32x2*)(zp + 2048 + col); raw.pk = *(const u32x2*)(zp + 2560 + col); raw.pv = *(const u32x2*)(zp + 3072 + col); \
                raw.pwl = *(const u32x2*)(zp + 3584 + pjg); raw.pal = *(const u32x2*)(zp + 3648 + pjg); if (PASS == 3) raw.pgl = *(const u32x4*)(zp + 3712 + 2 * pjg); } } while (0)
        SCAN_LOAD_RAW(0);
        for (int sub = 0; sub < SCH / 32; ++sub) {
            unsigned char* buf = lds + (sub & 1) * SBUF;
            {
                u32x2 ow_, oa_;
#pragma unroll
                for (int wi = 0; wi < 2; ++wi) { float t_[2], a_[2];
#pragma unroll
                    for (int e = 0; e < 2; ++e) { const int x = 2 * wi + e, sh = 16 * e;
                        const float cw = bf2f((bf16)(raw.cwl[wi] >> sh)), pw = bf2f((bf16)(raw.pwl[wi] >> sh)), ca = bf2f((bf16)(raw.cal[wi] >> sh)), pa = bf2f((bf16)(raw.pal[wi] >> sh));
                        const float zw = cw + mu_wl[x] * (pw - cw); t_[e] = 1.f - 2.f * __builtin_amdgcn_rcpf(1.f + __builtin_amdgcn_exp2f(zw * 2.8853900817779268f)); a_[e] = ca + mu_al[x] * (pa - ca); }
                    ow_[wi] = pk2(t_[0], t_[1]); oa_[wi] = pk2(a_[0], a_[1]); }
                *(u32x2*)(lds + O_AW + (ptt * 72 + pjg) * 2) = ow_; *(u32x2*)(lds + O_AA + (ptt * 72 + pjg) * 2) = oa_;
                if (PASS == 3) { u32x4 og_;
#pragma unroll
                    for (int wi = 0; wi < 4; ++wi) { float g_[2];
#pragma unroll
                        for (int e = 0; e < 2; ++e) { const int x = 2 * wi + e, sh = 16 * e; const float cg = bf2f((bf16)(raw.cgl[wi] >> sh)), pg = bf2f((bf16)(raw.pgl[wi] >> sh));
                            g_[e] = sigmoidf_(cg + (x < 4 ? mu_g0[x & 3] : mu_g1[x & 3]) * (pg - cg)); }
                        og_[wi] = pk2(g_[0], g_[1]); }
                    *(u32x4*)(lds + O_AG + (ptt * 136 + 2 * pjg) * 2) = og_; }
            }
            __syncthreads();
            {
                const bf16* AW = (const bf16*)(lds + O_AW); const bf16* AA = (const bf16*)(lds + O_AA); const bf16* AG = (const bf16*)(lds + O_AG);
                f32x4 cu = {0.f, 0.f, 0.f, 0.f}, ca = {0.f, 0.f, 0.f, 0.f}, cg = {0.f, 0.f, 0.f, 0.f};
#pragma unroll
                for (int ks = 0; ks < 2; ++ks) { cu = __builtin_amdgcn_mfma_f32_16x16x32_bf16(*(const bf16x8*)(AW + (16 * mrt + r16) * 72 + 32 * ks + q4 * 8), bw[ks], cu, 0, 0, 0);
                    ca = __builtin_amdgcn_mfma_f32_16x16x32_bf16(*(const bf16x8*)(AA + (16 * mrt + r16) * 72 + 32 * ks + q4 * 8), ba[ks], ca, 0, 0, 0); }
                if (PASS == 3) {
#pragma unroll
                    for (int ks = 0; ks < 4; ++ks) cg = __builtin_amdgcn_mfma_f32_16x16x32_bf16(*(const bf16x8*)(AG + (16 * mrt + r16) * 136 + 32 * ks + q4 * 8), bg[ks], cg, 0, 0, 0); }
#pragma unroll
                for (int jj = 0; jj < 4; ++jj) { const int o_ = (16 * mrt + q4 * 4 + jj) * 64 + 16 * mdt + r16;
                    *(float*)(lds + O_PU + o_ * 4) = cu[jj]; *(float*)(lds + O_PA + o_ * 4) = ca[jj]; if (PASS == 3) *(bf16*)(lds + O_PG + o_ * 2) = (bf16)f2bf(cg[jj]); }
            }
            __syncthreads();
            u32x2 gcur = {0u, 0u};
            if (PASS == 3) gcur = *(const u32x2*)(lds + O_PG + (ptt * 64 + pjg) * 2);
            const f32x4 upre = *(const f32x4*)(lds + O_PU + (ptt * 64 + pjg) * 4), apre = *(const f32x4*)(lds + O_PA + (ptt * 64 + pjg) * 4);
            {
                float r4[4], k4[4], v4[4], a4[4], kk[4]; float ss = 0.f;
#pragma unroll
                for (int x = 0; x < 4; ++x) { const int sh = 16 * (x & 1); const int wi = x >> 1;
                    const float zr = bf2f((bf16)(raw.cr[wi] >> sh)), zk = bf2f((bf16)(raw.ck[wi] >> sh)), zv = bf2f((bf16)(raw.cv[wi] >> sh));
                    const float qr = bf2f((bf16)(raw.pr[wi] >> sh)), qk = bf2f((bf16)(raw.pk[wi] >> sh)), qv = bf2f((bf16)(raw.pv[wi] >> sh));
                    r4[x] = zr + mu_r[x] * (qr - zr); k4[x] = zk + mu_k[x] * (qk - zk); v4[x] = zv + mu_v[x] * (qv - zv);
                    a4[x] = sigmoidf_(apre[x] + a0c[x]);
                    kk[x] = k4[x] * kkc[x]; ss += kk[x] * kk[x]; }
                ss = red16(ss);
                const float inv = __builtin_amdgcn_rsqf(fmaxf(ss, 1e-24f));
                float oA[4], oB[4], oW[4], oK[4]; float dot = 0.f;
#pragma unroll
                for (int x = 0; x < 4; ++x) { const float kn = kk[x] * inv; oA[x] = -kn; oB[x] = kn * a4[x];
                    oW[x] = __expf(-0.6065306597126334f * sigmoidf_(upre[x] + w0c[x]));
                    oK[x] = k4[x] * (1.f + (a4[x] - 1.f) * kac[x]); dot += r4[x] * oK[x] * rkc[x]; }
                const int o2 = (ptt * 64 + pjg) * 2;
                *(u32x2*)(buf + o2) = (u32x2){pkh(oA[0], oA[1]), pkh(oA[2], oA[3])}; *(u32x2*)(buf + O_B + o2) = (u32x2){pkh(oB[0], oB[1]), pkh(oB[2], oB[3])};
                *(u32x2*)(buf + O_W + o2) = (u32x2){pkh(oW[0], oW[1]), pkh(oW[2], oW[3])}; *(u32x2*)(buf + O_K + o2) = (u32x2){pkh(oK[0], oK[1]), pkh(oK[2], oK[3])};
                *(u32x4*)(buf + O_V2 + 2 * o2) = (u32x4){pkh(v4[0], v4[0]), pkh(v4[1], v4[1]), pkh(v4[2], v4[2]), pkh(v4[3], v4[3])};
                *(u32x2*)(buf + O_R + o2) = (u32x2){pkh(r4[0], r4[1]), pkh(r4[2], r4[3])};
                if (PASS == 3) *(f32x4*)(buf + O_VF + 2 * o2) = (f32x4){v4[0], v4[1], v4[2], v4[3]};
                dot = red16(dot); if ((tid & 15) == 0) *(float*)(buf + O_BON + ptt * 4) = dot;
            }
            __syncthreads();
            if (sub + 1 < SCH / 32) SCAN_LOAD_RAW(sub + 1);
            SCAN_STEPS(true)
            if (PASS == 1) {
                __syncthreads();
                const int t = c * SCH + sub * 32 + ptt; const size_t grow = (size_t)b * SEQ + t;
                const f32x4 y4 = *(const f32x4*)(buf + O_Y + (ptt * 64 + pjg) * 4), q4v = *(const f32x4*)(buf + O_VF + (ptt * 64 + pjg) * 4);
                *(u32x2*)(MIX + grow * DM + 512 + col) = (u32x2){pk2(y4[0], y4[1]), pk2(y4[2], y4[3])};
                *(u32x2*)(RHO + grow * 512 + col) = (u32x2){pk2(q4v[0], q4v[1]), pk2(q4v[2], q4v[3])};
                if ((tid & 15) == 0) BON[grow * 8 + h] = *(const float*)(buf + O_BON + ptt * 4);
            }
            if (PASS == 3) {
                __syncthreads();
                const int t = c * SCH + sub * 32 + ptt; const size_t grow = (size_t)b * SEQ + t;
                const f32x4 y4 = *(const f32x4*)(buf + O_Y + (ptt * 64 + pjg) * 4), v4 = *(const f32x4*)(buf + O_VF + (ptt * 64 + pjg) * 4);
                const float dot = *(const float*)(buf + O_BON + ptt * 4);
                const float mean = red16((y4[0] + y4[1]) + (y4[2] + y4[3])) * (1.f / 64.f);
                float qq = 0.f;
#pragma unroll
                for (int x = 0; x < 4; ++x) { const float d = y4[x] - mean; qq += d * d; }
                const float rstd = rsqrtf(red16(qq) * (1.f / 64.f) + 64e-5f);
                float o4[4];
#pragma unroll
                for (int x = 0; x < 4; ++x) { const float gate = bf2f((bf16)(gcur[x >> 1] >> (16 * (x & 1))));
                    o4[x] = ((y4[x] - mean) * rstd * lgc[x] + lbc[x] + dot * v4[x]) * gate; }
                u32x2 ow; ow.x = pk2(o4[0], o4[1]); ow.y = pk2(o4[2], o4[3]);
                *(u32x2*)(MIX + grow * DM + 512 + col) = ow;
            }
        }
#undef SCAN_LOAD_RAW
        if (PASS == 1) { float* du = Ub + ((size_t)u * 64 + rp) * 64 + j0; float* dp = Pb + ((size_t)u * 64 + rp) * 64 + j0;
            *(f32x4*)du = (f32x4){(float)SU[0][0], (float)SU[0][1], (float)SU[1][0], (float)SU[1][1]}; *(f32x4*)(du + 4) = (f32x4){(float)SU[2][0], (float)SU[2][1], (float)SU[3][0], (float)SU[3][1]};
            *(f32x4*)dp = (f32x4){(float)SP[0][0], (float)SP[0][1], (float)SP[1][0], (float)SP[1][1]}; *(f32x4*)(dp + 4) = (f32x4){(float)SP[2][0], (float)SP[2][1], (float)SP[3][0], (float)SP[3][1]}; }
    }
}
__device__ __forceinline__ void rwkv_out_phase(const bf16* Z, const RwkvW w, const bf16* Wl, const float* Ub, const bf16* RHO, const float* BON, bf16* MIX, unsigned char* lds) {
    bf16* Rs = (bf16*)lds; bf16* Ss = (bf16*)(lds + 18432); bf16* AG = (bf16*)(lds + 27648); bf16* Ys = (bf16*)(lds + 62464); bf16* Vs = (bf16*)(lds + 80896);
    const int tid = opaque_tid(), lane = tid & 63, wave = tid >> 6, r16 = lane & 15, q4 = lane >> 4;
    for (int u = opaque_bid(); u < 2048; u += gridDim.x) {
        const int bh = u >> 7, c = u & 127, b = bh >> 3, h = bh & 7, col0 = h * 64; const size_t rowbase = (size_t)b * SEQ + c * 128;
        __syncthreads();
        for (int ci = tid; ci < 1024; ci += NTHR) { const int j = ci >> 3, c8 = (ci & 7) * 8;
            *(u32x4*)(Rs + j * 72 + c8) = *(const u32x4*)(RHO + (rowbase + j) * 512 + col0 + c8);
            *(u32x4*)(Ys + j * 72 + c8) = *(const u32x4*)(MIX + (rowbase + j) * DM + 512 + col0 + c8);
            *(u32x4*)(Vs + (j + 1) * 72 + c8) = *(const u32x4*)(Z + (rowbase + j) * EVEN_IN + 3072 + col0 + c8); }
        if (tid < 8) { u32x4 pv = {0u, 0u, 0u, 0u}; if (c > 0) pv = *(const u32x4*)(Z + (rowbase - 1) * EVEN_IN + 3072 + col0 + tid * 8); *(u32x4*)(Vs + tid * 8) = pv; }
        for (int i4 = tid; i4 < 1024; i4 += NTHR) { const int i = i4 >> 4, k4 = (i4 & 15) * 4; f32x4 sv = {0.f, 0.f, 0.f, 0.f};
            if ((c >> SLOG) > 0) sv = *(const f32x4*)(Ub + (size_t)(bh * NCHK + (c >> SLOG) - 1) * 4096 + i * 64 + k4);
            *(u32x2*)(Ss + i * 72 + k4) = (u32x2){pk2(sv[0], sv[1]), pk2(sv[2], sv[3])}; }
        for (int ci = tid; ci < 2048; ci += NTHR) { const int j = ci >> 4, c8 = (ci & 15) * 8; const bf16* zc = Z + (rowbase + j) * EVEN_IN + 3712 + c8;
            const u32x4 cg = *(const u32x4*)zc; u32x4 pg = {0u, 0u, 0u, 0u}; if (c > 0 || j > 0) pg = *(const u32x4*)(zc - EVEN_IN);
            const f32x4 m0 = *(const f32x4*)(w.mu + 1664 + c8), m1 = *(const f32x4*)(w.mu + 1668 + c8); u32x4 og;
#pragma unroll
            for (int x = 0; x < 4; ++x) { const float c0 = __uint_as_float(cg[x] << 16), c1 = __uint_as_float(cg[x] & 0xffff0000u), p0 = __uint_as_float(pg[x] << 16), p1 = __uint_as_float(pg[x] & 0xffff0000u);
                const float ma = x < 2 ? m0[2 * x] : m1[2 * x - 4], mb = x < 2 ? m0[2 * x + 1] : m1[2 * x - 3];
                og[x] = pk2(sigmoidf_(c0 + ma * (p0 - c0)), sigmoidf_(c1 + mb * (p1 - c1))); }
            *(u32x4*)(AG + j * 136 + c8) = og; }
        __syncthreads();
        f32x4 ya[4], ga[4];
#pragma unroll
        for (int dt = 0; dt < 4; ++dt) { ya[dt] = (f32x4){0.f, 0.f, 0.f, 0.f}; ga[dt] = (f32x4){0.f, 0.f, 0.f, 0.f};
#pragma unroll
            for (int k0 = 0; k0 < 64; k0 += 32) ya[dt] = mma16(Rs, 72, 16 * wave, Ss, 72, 16 * dt, k0, ya[dt], lane);
            const bf16* wg = Wl + (size_t)(1024 + col0 + 16 * dt + r16) * 256 + 128 + q4 * 8;
#pragma unroll
            for (int ks = 0; ks < 4; ++ks) ga[dt] = __builtin_amdgcn_mfma_f32_16x16x32_bf16(*(const bf16x8*)(AG + (16 * wave + r16) * 136 + 32 * ks + q4 * 8), *(const bf16x8*)(wg + 32 * ks), ga[dt], 0, 0, 0); }
#pragma unroll
        for (int jj = 0; jj < 4; ++jj) { const int tl = 16 * wave + q4 * 4 + jj; const float bon = BON[(rowbase + tl) * 8 + h];
            float y[4]; float sum = 0.f;
#pragma unroll
            for (int dt = 0; dt < 4; ++dt) { y[dt] = ya[dt][jj] + bf2f(Ys[tl * 72 + 16 * dt + r16]); sum += y[dt]; }
            const float mean = red16(sum) * (1.f / 64.f); float qq = 0.f;
#pragma unroll
            for (int dt = 0; dt < 4; ++dt) { y[dt] -= mean; qq += y[dt] * y[dt]; }
            const float rstd = rsqrtf(red16(qq) * (1.f / 64.f) + 64e-5f);
#pragma unroll
            for (int dt = 0; dt < 4; ++dt) { const int ch = 16 * dt + r16; const float vc = bf2f(Vs[(tl + 1) * 72 + ch]), vp = bf2f(Vs[tl * 72 + ch]);
                const float vs = vc + w.mu[1024 + col0 + ch] * (vp - vc);
                Ys[tl * 72 + ch] = (bf16)f2bf((y[dt] * rstd * w.ln_g[col0 + ch] + w.ln_b[col0 + ch] + bon * vs) * ga[dt][jj]); } }
#pragma unroll
        for (int t2 = 0; t2 < 2; ++t2) { const int cidx = lane + 64 * t2, i = 16 * wave + (cidx >> 3), c8 = (cidx & 7) * 8;
            *(u32x4*)(MIX + (rowbase + i) * DM + 512 + col0 + c8) = *(const u32x4*)(Ys + i * 72 + c8); }
    }
}
template <bool STORE>
__device__ __forceinline__ void rwkv_combine_phase(const float* Pb, const float* Ub, float* Sb, unsigned char* lds) {
    float* s = (float*)lds; float* red = s + 256;
    const int tid = opaque_tid(), j = tid & 63, kq = tid >> 6;
    for (int item = opaque_bid(); item < 256; item += gridDim.x) {
        const int bh = item >> 4, rg = item & 15;
        __syncthreads();
        if (tid < 256) s[tid] = 0.f;
        __syncthreads();
        const float* Pc = Pb + (size_t)(bh * NCHK) * 4096 + (8 * kq) * 64 + j; const float* Uc = Ub + (size_t)(bh * NCHK) * 4096 + (4 * rg + (tid >> 6)) * 64 + j; float* Sc = Sb + (size_t)(bh * NCHK) * 4096 + (4 * rg + (tid >> 6)) * 64 + j;
        float pk[8], uv = 0.f;
#pragma unroll
        for (int x = 0; x < 8; ++x) pk[x] = Pc[x * 64];
        if (tid < 256) uv = Uc[0];
        for (int c = 0; c < NCHK; ++c) {
            float nk[8], nu = 0.f;
            if (c + 1 < NCHK) {
#pragma unroll
                for (int x = 0; x < 8; ++x) nk[x] = Pc[(size_t)(c + 1) * 4096 + x * 64];
                if (tid < 256) nu = Uc[(size_t)(c + 1) * 4096];
            } else {
#pragma unroll
                for (int x = 0; x < 8; ++x) nk[x] = 0.f;
            }
#pragma unroll
            for (int ri = 0; ri < 4; ++ri) { float a = 0.f;
#pragma unroll
                for (int x = 0; x < 8; ++x) a += s[ri * 64 + 8 * kq + x] * pk[x];
                red[(kq * 4 + ri) * 64 + j] = a; }
            __syncthreads();
            if (tid < 256) { const int ri = tid >> 6; float v = uv;
#pragma unroll
                for (int q = 0; q < 8; ++q) v += red[(q * 4 + ri) * 64 + j];
                s[tid] = v; if (STORE || v == 1.2345e-30f) Sc[(size_t)c * 4096] = v; }
            __syncthreads();
#pragma unroll
            for (int x = 0; x < 8; ++x) pk[x] = nk[x];
            uv = nu;
        }
    }
}

#define XB_TMO      128
#define XB_XCNT(j)  (256  + 64 * (j))
#define XB_XSUB(j)  (1280 + 64 * (j))
#define XB_XGEN(j)  (2304 + 64 * (j))
#define XB_TOP      3328
#define XB_TOPGEN   3392
#define XCD_BAR_WORDS 3456
#define XB_SPIN_CAP (1u << 18)

__device__ __forceinline__ unsigned xb_ld(unsigned* p)              { return __hip_atomic_load(p, __ATOMIC_RELAXED, __HIP_MEMORY_SCOPE_AGENT); }
__device__ __forceinline__ unsigned xb_add(unsigned* p, unsigned v) { return __hip_atomic_fetch_add(p, v, __ATOMIC_RELAXED, __HIP_MEMORY_SCOPE_AGENT); }
__device__ __forceinline__ unsigned xb_xcc_id() { return (unsigned)__builtin_amdgcn_s_getreg((3 << 11) | 20) & 0xFu; }
#define XB_SPIN(cond, bar) do { unsigned _sp = 0; while (cond) { __builtin_amdgcn_s_sleep(1); \
    if ((++_sp & 255u) == 0u) { if (xb_ld(&(bar)[XB_TMO])) break; if (_sp > XB_SPIN_CAP) { atomicAdd(&(bar)[XB_TMO], 1u); break; } } } } while (0)

struct XcdBarrier {
    unsigned* bar; unsigned x;
    volatile LAS unsigned* st;
};

__device__ __forceinline__ XcdBarrier xcd_barrier_post(unsigned* bar, volatile LAS unsigned* st) {
    XcdBarrier b; b.bar = bar; b.x = xb_xcc_id(); b.st = st;
    if (threadIdx.x == 0) (void)xb_add(&bar[XB_XCNT(b.x)], 1u);
    return b;
}
__device__ __forceinline__ void xcd_barrier_complete(unsigned* bar, unsigned x, unsigned& nloc, unsigned& nx) {
    const unsigned G = gridDim.x * gridDim.y * gridDim.z;
    unsigned sum, cnt, mine, sp = 0u;
    for (;;) {
        sum = 0u; cnt = 0u; mine = 0u;
#pragma unroll
        for (unsigned j = 0; j < 16; ++j) { const unsigned c = xb_ld(&bar[XB_XCNT(j)]); sum += c; cnt += (c > 0u) ? 1u : 0u; mine = (j == x) ? c : mine; }
        if (sum == G) break;
        __builtin_amdgcn_s_sleep(1);
        if ((++sp & 255u) == 0u) { if (xb_ld(&bar[XB_TMO])) break; if (sp > XB_SPIN_CAP) { atomicAdd(&bar[XB_TMO], 1u); break; } }
    }
    nloc = mine > 0u ? mine : 1u; nx = cnt > 0u ? cnt : 1u;
}

__device__ __forceinline__ void xcd_barrier(const XcdBarrier& b) {
    asm volatile("s_waitcnt vmcnt(0)" ::: "memory");
    __syncthreads();
    if (threadIdx.x == 0) {
        unsigned* bar = b.bar;
        __builtin_amdgcn_s_waitcnt(0);
        unsigned nloc = b.st[0], nx = b.st[1];
        if (nloc == 0u) { xcd_barrier_complete(bar, b.x, nloc, nx); b.st[0] = nloc; b.st[1] = nx; }
        const unsigned old = xb_add(&bar[XB_XSUB(b.x)], 1u);
        const unsigned gen = old / nloc;
        if (old + 1u == (gen + 1u) * nloc) {
            __builtin_amdgcn_fence(__ATOMIC_RELEASE, "agent");
            asm volatile("s_waitcnt vmcnt(0)" ::: "memory");
            const unsigned og = xb_add(&bar[XB_TOP], 1u);
            const unsigned tg = og / nx;
            if (og + 1u == (tg + 1u) * nx) xb_add(&bar[XB_TOPGEN], 1u);
            else XB_SPIN(xb_ld(&bar[XB_TOPGEN]) == tg, bar);
            __builtin_amdgcn_fence(__ATOMIC_ACQUIRE, "agent");
            xb_add(&bar[XB_XGEN(b.x)], 1u);
            asm volatile("s_waitcnt vmcnt(0)" ::: "memory");
        } else {
            XB_SPIN(xb_ld(&bar[XB_XGEN(b.x)]) == gen, bar);
            __builtin_amdgcn_fence(__ATOMIC_ACQUIRE, "agent");
            asm volatile("s_waitcnt vmcnt(0)" ::: "memory");
        }
    }
    __syncthreads();
}

enum { PH_INIT = 0, PH_INPROJ, PH_RETKV, PH_RETSCAN, PH_RETOUT, PH_LORA, PH_SCAN1, PH_COMBINE, PH_SCAN3, PH_SWA, PH_FFN1, PH_OUTPROJ, PH_RMS };
template <int PH, bool STORE = true>
__device__ __forceinline__ void do_phase(int layer, int part, unsigned char* lds) {
    ParamsPtr pq = (ParamsPtr)__builtin_amdgcn_kernarg_segment_ptr(); asm volatile("" : "+s"(pq));
#define p (*pq)
    bf16* wb = (bf16*)p.ws;
    bf16* Z = (bf16*)(p.ws + WS_Z); bf16* XN = (bf16*)(p.ws + WS_XN); float* Pb = p.out; float* Ub = p.out + 8388608; float* KVb = p.out + 16777216; float* Sb = p.out + 4194304; bf16* SPb = (bf16*)(p.out + 9437184); bf16* RHO = (bf16*)(p.out + 25165824); float* BON = (float*)(p.ws + WS_BON);
    bf16* RB = (bf16*)(p.ws + WS_RB); float* SSQ = (float*)(p.ws + WS_SSQ);
    const int i = layer >> 1; const bool even = (layer & 1) == 0;
    if constexpr (PH == PH_INIT) { weights_phase(pq, lds); init_rows_phase(p.x, RB, SSQ); rope_table_phase((f32x2v*)(p.ws + WS_ROPE)); }
    if constexpr (PH == PH_INPROJ) {
        const bf16* Bt = even ? wb + E_WIN + (size_t)i * 3840 * 1024 : wb + E_WQKV + (size_t)i * 1536 * 1024;
        const int N = even ? EVEN_IN : QKVW;
        EpiStore E{Z, N, even ? nullptr : p.swa_b_qkv + i * QKVW, (const float*)(lds + RSTD_OFF), 0}; run_gemm_norm(lds, RB, Bt, MTOK, N, DM, E, SSQ + (size_t)(2 * layer) * MTOK * 16);
    }
    if constexpr (PH == PH_RETKV || PH == PH_RETOUT) {
        const RwkvW rw{p.rwkv_mu + i * 1792, p.rwkv_k_k + i * 512, p.rwkv_k_a + i * 512, p.rwkv_r_k + i * 512, p.rwkv_ln_g + i * 512, p.rwkv_ln_b + i * 512, p.rwkv_w0 + i * 512, p.rwkv_a0 + i * 512};
        const bf16* Wl = wb + E_WL + (size_t)i * 1536 * 256;
        if constexpr (PH == PH_RETKV) { ret_kv_phase(Z, KVb, (const f32x2v*)(p.ws + WS_ROPE), lds); __syncthreads(); rwkv_scan_phase<1>(Z, rw, Wl, Pb, Ub, XN, RHO, BON, lds); }
        else { ret_out_phase(Z, SPb, XN, lds); __syncthreads(); rwkv_out_phase(Z, rw, Wl, Sb, RHO, BON, XN, lds); }
    }
    if constexpr (PH == PH_RETSCAN) { ret_scan_phase<STORE>(KVb, SPb); rwkv_combine_phase<STORE>(Pb, Ub, Sb, lds); }
    if constexpr (PH == PH_SWA) swa_phase(Z, XN, p.swa_sinks + i * 16, lds);
    if constexpr (PH == PH_FFN1) { EpiSwiglu E{Z, FF, (const float*)(lds + RSTD_OFF), 0}; run_gemm_norm(lds, RB, wb + E_WGU + (size_t)layer * 5632 * 1024, MTOK, 2 * FF, DM, E, SSQ + (size_t)(2 * layer + 1) * MTOK * 16); }
    if constexpr (PH == PH_OUTPROJ) {
        const bf16* A = part == 0 ? XN : Z;
        const bf16* Bt = part == 0 ? (even ? wb + E_WOUT + (size_t)i * 1024 * 1024 : wb + E_WO + (size_t)i * 1024 * 1024) : wb + E_WD + (size_t)layer * 1024 * FF;
        const float* bias = (part == 0 && !even) ? p.swa_b_o + i * DM : nullptr;
        EpiRes E{RB, DM, bias, SSQ + (size_t)(part == 0 ? 2 * layer + 1 : (layer < 3 ? 2 * layer + 2 : 7)) * MTOK * 16}; run_gemm(lds, A, Bt, MTOK, DM, part == 0 ? DM : FF, E);
    }
    if constexpr (PH == PH_RMS) {
        final_rms_phase(RB, p.final_g, p.out);
    }
#undef p
}

#ifndef FUSED
#define FUSED 1
#endif
#ifndef PROBE_MASK
#define PROBE_MASK 0
#endif
#if FUSED
__global__ void __launch_bounds__(NTHR, 2) trunk_fwd(Params p) {
    extern __shared__ __attribute__((aligned(16))) unsigned char lds[];
    cg::grid_group grid = cg::this_grid();
    volatile LAS unsigned* misc = (volatile LAS unsigned*)((LAS unsigned char*)lds + MISC_OFF);
    if (threadIdx.x < 16) misc[threadIdx.x] = 0u;
    __syncthreads();
    XcdBarrier bar = xcd_barrier_post((unsigned*)(((const Params __attribute__((address_space(4)))*)__builtin_amdgcn_kernarg_segment_ptr())->ws + WS_CTL), misc);
    do_phase<PH_INIT>(0, 0, lds);
    grid.sync();
    if (PROBE_MASK & 1) { do_phase<PH_INIT>(0, 0, lds); xcd_barrier(bar); }
#define GSYNC() do { xcd_barrier(bar); if (PROBE_MASK & 0x8000) xcd_barrier(bar); } while (0)
#define RUN(PH) do { if (PROBE_MASK & (1 << PH)) { do_phase<PH, false>(layer, part, lds); GSYNC(); } do_phase<PH>(layer, part, lds); GSYNC(); } while (0)
    for (int hl = 0; hl < 8; ++hl) {
        const int layer = hl >> 1, part = hl & 1;
        if (part == 0) {
            RUN(PH_INPROJ);
            if ((layer & 1) == 0) {
                RUN(PH_RETKV);
                RUN(PH_RETSCAN);
                RUN(PH_RETOUT);
            } else {
                RUN(PH_SWA);
            }
        } else {
            RUN(PH_FFN1);
        }
        RUN(PH_OUTPROJ);
        if (hl == 7) do_phase<PH_RMS>(layer, part, lds);
    }
}
#else
template <int PH>
__global__ void __launch_bounds__(NTHR, 2) phase_k(Params p, int layer, int part) {
    extern __shared__ __attribute__((aligned(16))) unsigned char lds[];
    do_phase<PH>(layer, part, lds);
}
#endif

extern "C" void kernel_launch(void* const* d_in, const int* in_sizes, int n_in, void* d_out, int out_size, void* d_ws, size_t ws_size, hipStream_t stream) {
    static int grid = 0;
    if (grid == 0) {
        if (n_in != 25 || out_size != MTOK * DM || ws_size < WS_END) { fprintf(stderr, "kernel_launch: unexpected shapes (n_in %d out %d ws %zu)\n", n_in, out_size, ws_size); grid = -1; return; }
        int dev = 0, cus = 0;
        (void)hipGetDevice(&dev); (void)hipDeviceGetAttribute(&cus, hipDeviceAttributeMultiprocessorCount, dev);
#if FUSED
        int per_cu = 0;
        (void)hipFuncSetAttribute((const void*)trunk_fwd, hipFuncAttributeMaxDynamicSharedMemorySize, LDS_BYTES);
        (void)hipOccupancyMaxActiveBlocksPerMultiprocessor(&per_cu, (const void*)trunk_fwd, NTHR, LDS_BYTES);
        grid = cus > 0 ? cus : 256;
#else
#define SETATTR(PH) (void)hipFuncSetAttribute((const void*)phase_k<PH>, hipFuncAttributeMaxDynamicSharedMemorySize, LDS_BYTES)
        SETATTR(PH_INIT); SETATTR(PH_INPROJ); SETATTR(PH_RETKV); SETATTR(PH_RETSCAN); SETATTR(PH_RETOUT); SETATTR(PH_LORA); SETATTR(PH_SCAN1); SETATTR(PH_COMBINE);
        SETATTR(PH_SCAN3); SETATTR(PH_SWA); SETATTR(PH_FFN1); SETATTR(PH_OUTPROJ); SETATTR(PH_RMS);
        grid = cus;
#endif
        (void)hipGetLastError();
    }
    if (grid < 0) return;
    Params p{};
    const float** pp = (const float**)&p;
    for (int i = 0; i < 25; ++i) pp[i] = (const float*)d_in[i];
    p.out = (float*)d_out; p.ws = (unsigned char*)d_ws;
#if FUSED
    (void)hipMemsetAsync((char*)d_ws + WS_CTL, 0, CTL_BYTES, stream);
    void* args[] = {&p};
    hipError_t e = hipLaunchCooperativeKernel((const void*)trunk_fwd, dim3(grid), dim3(NTHR), args, LDS_BYTES, stream);
    if (e != hipSuccess) fprintf(stderr, "cooperative launch failed: %s (grid %d)\n", hipGetErrorString(e), grid);
#else
#define LAUNCH(PH, layer, part) hipLaunchKernelGGL(phase_k<PH>, dim3(grid), dim3(NTHR), LDS_BYTES, stream, p, layer, part)
    LAUNCH(PH_INIT, 0, 0);
    for (int hl = 0; hl < 8; ++hl) {
        const int layer = hl >> 1, part = hl & 1;
        if (part == 0) {
            LAUNCH(PH_INPROJ, layer, part);
            if ((layer & 1) == 0) { LAUNCH(PH_RETKV, layer, part); LAUNCH(PH_RETSCAN, layer, part); LAUNCH(PH_RETOUT, layer, part); }
            else LAUNCH(PH_SWA, layer, part);
        } else LAUNCH(PH_FFN1, layer, part);
        LAUNCH(PH_OUTPROJ, layer, part);
        if (hl == 7) LAUNCH(PH_RMS, layer, part);
    }
#endif
}
```
